# Optimizing an MI355X kernel written in HIP

```python
import functools
import jax, jax.numpy as jnp
from jax import lax
import numpy as np

D_MODEL = 1024
BATCH = 32
SEQ = 2048
DEPTH = 4
DEC_BATCH = 8
DEC_SEQ = 32
PAST_LEN = 1024

CHUNK = 64
N_META = 16
H_GLA = 4
DK_GLA = D_MODEL // 2 // H_GLA
DV_GLA = D_MODEL // H_GLA
GATE_RANK = 16
GATE_TAU = 16.0
H_RET = 4
DK_RET = D_MODEL // 2 // H_RET
DV_RET = D_MODEL // H_RET
D_FF = 2816
ROPE_BASE = 10000.0
LN_EPS = 1e-5
GN_EPS = 1e-5
DN_ALPHA = (2.0 * DEPTH) ** 0.25
DN_BETA = (8.0 * DEPTH) ** -0.25
IN_SIZES = (H_GLA * DK_GLA, H_GLA * DK_GLA, H_GLA * DV_GLA, H_GLA * DV_GLA, GATE_RANK,
            H_RET * DK_RET, H_RET * DK_RET, H_RET * DV_RET, H_RET * DV_RET, 2 * D_MODEL)
N_IN = sum(IN_SIZES)

kernel_name = 'gla_retnet_macaron_deepnorm_meta_stream'

F32 = jnp.float32


def layer_norm(x, g, b):
    xf = x.astype(F32)
    mu = xf.mean(-1, keepdims=True)
    var = jnp.mean(jnp.square(xf - mu), -1, keepdims=True)
    return ((xf - mu) * lax.rsqrt(var + LN_EPS) * g.astype(F32) + b.astype(F32)).astype(x.dtype)


def head_norm(o, g):
    mu = o.mean(-1, keepdims=True)
    var = jnp.mean(jnp.square(o - mu), -1, keepdims=True)
    on = (o - mu) * lax.rsqrt(var + GN_EPS)
    return on.reshape(o.shape[0], o.shape[1], -1) * g.astype(F32)


def swiglu(x, w_up, w_down):
    a, b = jnp.split(x @ w_up, 2, axis=-1)
    return (jax.nn.silu(a) * b) @ w_down


def rotary(x, pos):
    half = x.shape[-1] // 2
    inv = ROPE_BASE ** (-jnp.arange(half, dtype=F32) / half)
    ang = pos.astype(F32)[:, None] * inv[None, :]
    cos = jnp.cos(ang)[None, :, None, :]
    sin = jnp.sin(ang)[None, :, None, :]
    x1, x2 = x[..., :half], x[..., half:]
    return jnp.concatenate([x1 * cos - x2 * sin, x2 * cos + x1 * sin], axis=-1)


def gla_block(s0, q, k, v, lg):
    L = q.shape[1]
    b = jnp.cumsum(lg, axis=1)
    o_inter = jnp.einsum('blhd,bhde->blhe', q * jnp.exp(b), s0)
    causal = (jnp.arange(L)[:, None] >= jnp.arange(L)[None, :])[None, :, :, None, None]
    dec = jnp.exp(jnp.where(causal, b[:, :, None] - b[:, None, :], -jnp.inf))
    att = jnp.einsum('bthd,bshd,btshd->bhts', q, k, dec)
    o = o_inter + jnp.einsum('bhts,bshe->bthe', att, v)
    b_last = b[:, -1]
    s_new = jnp.exp(b_last)[..., None] * s0 + jnp.einsum(
        'bshd,bshe->bhde', k * jnp.exp(b_last[:, None] - b), v)
    return o, s_new


def ret_block(s0, q, k, v, log_gamma):
    L = q.shape[1]
    idx = jnp.arange(L, dtype=F32)
    inter = jnp.exp((idx + 1.0)[:, None] * log_gamma[None, :])
    o_inter = jnp.einsum('blhd,bhde->blhe', q, s0) * inter[None, :, :, None]
    rel = idx[:, None] - idx[None, :]
    dmat = jnp.exp(jnp.where(rel[..., None] >= 0, rel[..., None] * log_gamma, -jnp.inf))
    att = jnp.einsum('bthd,bshd->bhts', q, k) * jnp.transpose(dmat, (2, 0, 1))[None]
    o = o_inter + jnp.einsum('bhts,bshe->bthe', att, v)
    tail = jnp.exp((L - 1.0 - idx)[:, None] * log_gamma[None, :])
    s_new = jnp.exp(L * log_gamma)[None, :, None, None] * s0 + jnp.einsum(
        'bshd,bshe->bhde', k * tail[None, :, :, None], v)
    return o, s_new


def run_mixer(step, s0, xs, prompt):
    if not prompt:
        return step(s0, *xs)
    o_meta, s = step(s0, *tuple(a[:, :N_META] for a in xs))
    B, T = xs[0].shape[:2]
    t_rest = T - N_META
    n = t_rest // CHUNK
    chunks = tuple(a[:, N_META:].reshape(B, n, CHUNK, *a.shape[2:]).swapaxes(0, 1) for a in xs)

    def body(carry, c):
        o, carry = step(carry, *c)
        return carry, o

    s, o = lax.scan(body, s, chunks)
    o = o.swapaxes(0, 1).reshape(B, t_rest, *o.shape[3:])
    return jnp.concatenate([o_meta, o], axis=1), s


def layer(h, pos, s_gla, s_ret, prompt, ln_g, ln_b, w1u, w1d, w_in, w_a2, b_a, b_m,
          g_gla, g_ret, w_oa, w_ob, w_o, w2u, w2d):
    B, T, _ = h.shape
    h = layer_norm(DN_ALPHA * h + 0.5 * swiglu(h, w1u, w1d), ln_g[0], ln_b[0])
    z = h @ w_in
    cuts = [int(c) for c in np.cumsum(IN_SIZES)[:-1]]
    qg, kg, vg, rg, ag, qr, kr, vr, gr, mg = jnp.split(z, cuts, axis=-1)
    q = qg.astype(F32).reshape(B, T, H_GLA, DK_GLA) * DK_GLA ** -0.5
    k = kg.astype(F32).reshape(B, T, H_GLA, DK_GLA)
    v = vg.astype(F32).reshape(B, T, H_GLA, DV_GLA)
    lg = (jax.nn.log_sigmoid((ag @ w_a2 + b_a).astype(F32)) / GATE_TAU).reshape(B, T, H_GLA, DK_GLA)
    o_a, s_gla = run_mixer(gla_block, s_gla.astype(F32), (q, k, v, lg), prompt)
    ya = (jax.nn.silu(rg) * head_norm(o_a, g_gla).astype(h.dtype)) @ w_oa
    log_gamma = jnp.log1p(-(2.0 ** (-5.0 - jnp.arange(H_RET, dtype=F32))))
    q = rotary(qr.astype(F32).reshape(B, T, H_RET, DK_RET), pos)
    k = rotary(kr.astype(F32).reshape(B, T, H_RET, DK_RET), pos) * DK_RET ** -0.5
    v = vr.astype(F32).reshape(B, T, H_RET, DV_RET)
    step_r = functools.partial(ret_block, log_gamma=log_gamma)
    o_b, s_ret = run_mixer(step_r, s_ret.astype(F32), (q, k, v), prompt)
    yb = (jax.nn.silu(gr) * head_norm(o_b, g_ret).astype(h.dtype)) @ w_ob
    ga, gb = jnp.split(jax.nn.sigmoid(mg + b_m), 2, axis=-1)
    h = layer_norm(DN_ALPHA * h + (ga * ya + gb * yb) @ w_o, ln_g[1], ln_b[1])
    h = layer_norm(DN_ALPHA * h + 0.5 * swiglu(h, w2u, w2d), ln_g[2], ln_b[2])
    return h, s_gla, s_ret


def setup_inputs(seed: int = 0) -> dict:
    key = jax.random.key(seed)
    ks = jax.random.split(key, 24)
    n = jax.random.normal
    d = D_MODEL
    return {
        'x_prompt': n(ks[0], (BATCH, SEQ, d), F32),
        'x_sample': n(ks[1], (DEC_BATCH, DEC_SEQ, d), F32),
        'state_gla': n(ks[2], (DEPTH, DEC_BATCH, H_GLA, DK_GLA, DV_GLA), F32),
        'state_ret': n(ks[3], (DEPTH, DEC_BATCH, H_RET, DK_RET, DV_RET), F32),
        'meta': n(ks[4], (N_META, d), F32),
        'ln_g': 1.0 + 0.02 * n(ks[5], (DEPTH, 3, d), F32),
        'ln_b': 0.02 * n(ks[6], (DEPTH, 3, d), F32),
        'w_ffn1_up': n(ks[7], (DEPTH, d, 2 * D_FF), F32) * d ** -0.5,
        'w_ffn1_down': n(ks[8], (DEPTH, D_FF, d), F32) * (D_FF ** -0.5 * DN_BETA),
        'w_in': n(ks[9], (DEPTH, d, N_IN), F32) * d ** -0.5,
        'w_alpha2': n(ks[10], (DEPTH, GATE_RANK, H_GLA * DK_GLA), F32) * GATE_RANK ** -0.5,
        'b_alpha': 0.1 * n(ks[11], (DEPTH, H_GLA * DK_GLA), F32),
        'b_merge': 0.1 * n(ks[12], (DEPTH, 2 * d), F32),
        'gn_gla': 1.0 + 0.02 * n(ks[13], (DEPTH, H_GLA * DV_GLA), F32),
        'gn_ret': 1.0 + 0.02 * n(ks[14], (DEPTH, H_RET * DV_RET), F32),
        'w_o_gla': n(ks[15], (DEPTH, H_GLA * DV_GLA, d), F32) * ((H_GLA * DV_GLA) ** -0.5 * DN_BETA),
        'w_o_ret': n(ks[16], (DEPTH, H_RET * DV_RET, d), F32) * ((H_RET * DV_RET) ** -0.5 * DN_BETA),
        'w_out': n(ks[17], (DEPTH, d, d), F32) * (d ** -0.5 * DN_BETA),
        'w_ffn2_up': n(ks[18], (DEPTH, d, 2 * D_FF), F32) * d ** -0.5,
        'w_ffn2_down': n(ks[19], (DEPTH, D_FF, d), F32) * (D_FF ** -0.5 * DN_BETA),
    }


def reference(x_prompt, x_sample, state_gla, state_ret, meta, ln_g, ln_b, w_ffn1_up, w_ffn1_down,
              w_in, w_alpha2, b_alpha, b_merge, gn_gla, gn_ret, w_o_gla, w_o_ret, w_out,
              w_ffn2_up, w_ffn2_down):
    b_p = x_prompt.shape[0]
    hp = jnp.concatenate(
        [jnp.broadcast_to(meta[None].astype(x_prompt.dtype), (b_p, N_META, D_MODEL)), x_prompt], axis=1)
    hs = x_sample
    pos_p = jnp.arange(N_META + x_prompt.shape[1], dtype=jnp.int32)
    pos_s = N_META + PAST_LEN + jnp.arange(x_sample.shape[1], dtype=jnp.int32)
    zg = jnp.zeros((b_p, H_GLA, DK_GLA, DV_GLA), F32)
    zr = jnp.zeros((b_p, H_RET, DK_RET, DV_RET), F32)
    gla_p, ret_p, gla_s, ret_s = [], [], [], []
    for l in range(DEPTH):
        lw = (ln_g[l], ln_b[l], w_ffn1_up[l], w_ffn1_down[l], w_in[l], w_alpha2[l], b_alpha[l],
              b_merge[l], gn_gla[l], gn_ret[l], w_o_gla[l], w_o_ret[l], w_out[l],
              w_ffn2_up[l], w_ffn2_down[l])
        hp, sg, sr = layer(hp, pos_p, zg, zr, True, *lw)
        gla_p.append(sg.astype(x_prompt.dtype))
        ret_p.append(sr.astype(x_prompt.dtype))
        hs, sg, sr = layer(hs, pos_s, state_gla[l], state_ret[l], False, *lw)
        gla_s.append(sg.astype(state_gla.dtype))
        ret_s.append(sr.astype(state_ret.dtype))
    y_prompt = hp[:, N_META:]
    y_sample = hs
    new_gla_prompt = jnp.stack(gla_p, axis=0)
    new_ret_prompt = jnp.stack(ret_p, axis=0)
    new_gla_sample = jnp.stack(gla_s, axis=0)
    new_ret_sample = jnp.stack(ret_s, axis=0)
    return (y_prompt, y_sample, new_gla_prompt, new_ret_prompt, new_gla_sample, new_ret_sample)
```

```cpp
#include <hip/hip_runtime.h>
#include <hip/hip_cooperative_groups.h>
#include <cstdio>
namespace cg = cooperative_groups;

#define LAS __attribute__((address_space(3)))
typedef unsigned short bf16_t;
typedef short bf16x8 __attribute__((ext_vector_type(8)));
typedef short s16x4 __attribute__((ext_vector_type(4)));
typedef float f32x4 __attribute__((ext_vector_type(4)));
typedef float f32x2 __attribute__((ext_vector_type(2)));
typedef unsigned u32x4 __attribute__((ext_vector_type(4)));
typedef unsigned u32x2 __attribute__((ext_vector_type(2)));

constexpr int DM = 1024, DFF = 2816, NZ = 8704, DEPTH_ = 4;
constexpr int MBIG = 32768, MSMALL = 512, NPOS = 2064;
constexpr float DN_ALPHA_ = 1.681792830507429f;
constexpr float LN_EPS_ = 1e-5f, GN_EPS_ = 1e-5f;
constexpr size_t OUT_YP = 0, OUT_YS = 67108864, OUT_GLA_P = 67371008, OUT_RET_P = 84148224, OUT_GLA_S = 100925440, OUT_RET_S = 105119744;
constexpr size_t W_UP1 = 0, W_DN1 = 5767168, W_IN = 8650752, W_OA = 17563648, W_OB = 18612224, W_O = 19660800, W_UP2 = 20709376, W_DN2 = 26476544, W_LAYER = 29360128;
constexpr size_t WS_CTL = 0, WS_TRIG = 65536, WS_SMETA = WS_TRIG + 2097152, WS_W = WS_SMETA + 4194304, WS_HB = WS_W + W_LAYER * 2 * 4,
                 WS_Z = WS_HB + (size_t)MBIG * DM * 2, WS_END = WS_Z + (size_t)MBIG * NZ * 2;
constexpr int LDS_BYTES = 139520;

__device__ __forceinline__ unsigned cvt_pk_bf16(float lo, float hi) { unsigned r; asm volatile("v_cvt_pk_bf16_f32 %0, %1, %2" : "=v"(r) : "v"(lo), "v"(hi)); return r; }
__device__ __forceinline__ float bf_lo(unsigned w) { return __uint_as_float(w << 16); }
__device__ __forceinline__ float bf_hi(unsigned w) { return __uint_as_float(w & 0xffff0000u); }
__device__ __forceinline__ float fast_sigmoid(float x) { return __builtin_amdgcn_rcpf(1.0f + __expf(-x)); }
__device__ __forceinline__ float fast_silu(float x) { return x * fast_sigmoid(x); }

namespace pg8 {
#define PG8_LAS __attribute__((address_space(3)))
typedef unsigned short bf16_t;
typedef short bf16x8 __attribute__((ext_vector_type(8)));
typedef float f32x4 __attribute__((ext_vector_type(4)));
typedef unsigned u32x4 __attribute__((ext_vector_type(4)));
constexpr int BM = 256, BK = 64, HALF = 128, HTB = HALF * BK * 2  , STAGE_BYTES = 8 * HTB, NXCD = 8, WGM = 8;

__host__ __device__ __forceinline__ int lds_byte(int r, int c) { const int st = (r >> 4) * 2 + (c >> 5), rr = r & 15, cc = c & 31, ob = rr * 64 + cc * 2; return st * 1024 + (ob ^ (((ob >> 9) & 1) << 5)); }
__host__ __device__ __forceinline__ void stage_rc(int b, int& R, int& C) { const int st = b / 1024, sb = b % 1024, swz = sb ^ (((sb >> 9) & 1) << 5); R = (st >> 1) * 16 + swz / 64; C = (st & 1) * 32 + (swz % 64) / 2; }
__host__ __device__ __forceinline__ int perm32(int rho) { const int n = rho >> 4, i = rho & 15; return 8 * (i >> 2) + 4 * n + (i & 3); }

struct Unit { int pm, pn; };
struct Gemm { const bf16_t* A; const bf16_t* Bt; int M, N, K; };

struct StaticOrder {
    int nM, nN, nwg, G, c;
    __host__ __device__ void init(int M, int N, int G_, int c_) { nM = M / BM; nN = N / BM; nwg = nM * nN; G = G_; c = c_; }
    __host__ __device__ bool next(int i, Unit& u) const {
        const long L = (long)i * G + c; if (L >= nwg) return false;
        int wgid = (int)L; { const int q = nwg / NXCD, r = nwg % NXCD, xcd = wgid % NXCD, off = wgid / NXCD; wgid = (xcd < r ? xcd * (q + 1) : r * (q + 1) + (xcd - r) * q) + off; }
        const int nig = WGM * nN, gid = wgid / nig, fm = gid * WGM, gsz = (nM - fm) < WGM ? (nM - fm) : WGM;
        u.pm = fm + ((wgid % nig) % gsz); u.pn = (wgid % nig) / gsz; return true;
    }
    __device__ __forceinline__ void a_ready(const Unit&) const {}
    __device__ __forceinline__ void done(const Unit&) const {}
};


struct EpiSwiglu {
    static constexpr bool PERM = true, AFTER_DRAIN = false;
    bf16_t* U; int ldc;
    __device__ __forceinline__ void operator()(const f32x4 (&acc)[2][2][4][2], const Unit& u, int wr, int wc, int fr, int fq) const {
        const int row0 = u.pm * BM + wr * 64 + fr, col0 = u.pn * 128 + wc * 32 + 8 * fq;
#pragma unroll
        for (int ai = 0; ai < 2; ++ai)
#pragma unroll
            for (int m = 0; m < 4; ++m) {
                bf16_t* rowp = U + (size_t)(row0 + ai * HALF + m * 16) * ldc + col0;
                const f32x4 a0 = acc[ai][0][m][0], a1 = acc[ai][0][m][1], b0 = acc[ai][1][m][0], b1 = acc[ai][1][m][1];
                u32x4 w;
                w.x = cvt_pk_bf16(fast_silu(a0[0]) * b0[0], fast_silu(a0[1]) * b0[1]); w.y = cvt_pk_bf16(fast_silu(a0[2]) * b0[2], fast_silu(a0[3]) * b0[3]);
                w.z = cvt_pk_bf16(fast_silu(a1[0]) * b1[0], fast_silu(a1[1]) * b1[1]); w.w = cvt_pk_bf16(fast_silu(a1[2]) * b1[2], fast_silu(a1[3]) * b1[3]);
                *(u32x4*)rowp = w;
            }
    }
};
struct EpiResid {
    static constexpr bool PERM = false, AFTER_DRAIN = false;
    float* H; float alpha, s;
    __device__ __forceinline__ void operator()(const f32x4 (&acc)[2][2][4][2], const Unit& u, int wr, int wc, int fr, int fq) const {
        const int row0 = u.pm * BM + wr * 64 + fr, col0 = u.pn * BM + wc * 32 + 4 * fq;
#pragma unroll
        for (int ai = 0; ai < 2; ++ai)
#pragma unroll
            for (int m = 0; m < 4; ++m) { float* rowp = H + (size_t)(row0 + ai * HALF + m * 16) * DM + col0;
#pragma unroll
                for (int bj = 0; bj < 2; ++bj)
#pragma unroll
                    for (int n = 0; n < 2; ++n) { float* p = rowp + bj * HALF + n * 16; const f32x4 h = *(const f32x4*)p; *(f32x4*)p = h * alpha + acc[ai][bj][m][n] * s; } }
    }
};
struct EpiZ {
    static constexpr bool PERM = true, AFTER_DRAIN = false;
    bf16_t* Z; int M;
    __device__ __forceinline__ void operator()(const f32x4 (&acc)[2][2][4][2], const Unit& u, int wr, int wc, int fr, int fq) const {
        const int pn = u.pn; int ts, cs, wd;
        if (pn < 2) { ts = 0; cs = 0; wd = 512; } else if (pn < 4) { ts = 2; cs = 512; wd = 512; } else if (pn < 8) { ts = 4; cs = 1024; wd = 1024; } else if (pn < 12) { ts = 8; cs = 2048; wd = 1024; }
        else if (pn < 14) { ts = 12; cs = 3072; wd = 512; } else if (pn < 16) { ts = 14; cs = 3584; wd = 512; } else if (pn < 18) { ts = 16; cs = 4096; wd = 512; } else if (pn < 22) { ts = 18; cs = 4608; wd = 1024; }
        else if (pn < 26) { ts = 22; cs = 5632; wd = 1024; } else { ts = 26; cs = 6656; wd = 2048; }
        bf16_t* base = Z + (size_t)M * cs;
        const int row0 = u.pm * BM + wr * 64 + fr, col0 = (pn - ts) * BM + wc * 32 + 8 * fq;
#pragma unroll
        for (int ai = 0; ai < 2; ++ai)
#pragma unroll
            for (int m = 0; m < 4; ++m) { bf16_t* rowp = base + (size_t)(row0 + ai * HALF + m * 16) * wd + col0;
#pragma unroll
                for (int bj = 0; bj < 2; ++bj) { const f32x4 v0 = acc[ai][bj][m][0], v1 = acc[ai][bj][m][1];
                    u32x4 w; w.x = cvt_pk_bf16(v0[0], v0[1]); w.y = cvt_pk_bf16(v0[2], v0[3]); w.z = cvt_pk_bf16(v1[0], v1[1]); w.w = cvt_pk_bf16(v1[2], v1[3]);
                    *(u32x4*)(rowp + bj * HALF) = w; } }
    }
};
template <bool ADD> struct EpiGate {
    static constexpr bool PERM = true, AFTER_DRAIN = false;
    const bf16_t* MG; const float* bm; int goff; const bf16_t* prev; bf16_t* out;
    __device__ __forceinline__ void operator()(const f32x4 (&acc)[2][2][4][2], const Unit& u, int wr, int wc, int fr, int fq) const {
        const int row0 = u.pm * BM + wr * 64 + fr, col0 = u.pn * BM + wc * 32 + 8 * fq;
#pragma unroll
        for (int ai = 0; ai < 2; ++ai)
#pragma unroll
            for (int m = 0; m < 4; ++m) { const size_t row = (size_t)(row0 + ai * HALF + m * 16);
#pragma unroll
                for (int bj = 0; bj < 2; ++bj) { const int c = col0 + bj * HALF;
                    const u32x4 g = *(const u32x4*)(MG + row * 2048 + goff + c);
                    const f32x4 bA = *(const f32x4*)(bm + goff + c), bB = *(const f32x4*)(bm + goff + c + 4);
                    const f32x4 v0 = acc[ai][bj][m][0], v1 = acc[ai][bj][m][1];
                    float r[8];
                    r[0] = fast_sigmoid(bf_lo(g.x) + bA[0]) * v0[0]; r[1] = fast_sigmoid(bf_hi(g.x) + bA[1]) * v0[1];
                    r[2] = fast_sigmoid(bf_lo(g.y) + bA[2]) * v0[2]; r[3] = fast_sigmoid(bf_hi(g.y) + bA[3]) * v0[3];
                    r[4] = fast_sigmoid(bf_lo(g.z) + bB[0]) * v1[0]; r[5] = fast_sigmoid(bf_hi(g.z) + bB[1]) * v1[1];
                    r[6] = fast_sigmoid(bf_lo(g.w) + bB[2]) * v1[2]; r[7] = fast_sigmoid(bf_hi(g.w) + bB[3]) * v1[3];
                    if (ADD) { const u32x4 p = *(const u32x4*)(prev + row * DM + c);
                        r[0] += bf_lo(p.x); r[1] += bf_hi(p.x); r[2] += bf_lo(p.y); r[3] += bf_hi(p.y); r[4] += bf_lo(p.z); r[5] += bf_hi(p.z); r[6] += bf_lo(p.w); r[7] += bf_hi(p.w); }
                    u32x4 w; w.x = cvt_pk_bf16(r[0], r[1]); w.y = cvt_pk_bf16(r[2], r[3]); w.z = cvt_pk_bf16(r[4], r[5]); w.w = cvt_pk_bf16(r[6], r[7]);
                    *(u32x4*)(out + row * DM + c) = w; } }
    }
};

template <class Epi, class Sched, bool STAMP = false>
__device__ __forceinline__ void gemm_phase(PG8_LAS unsigned char* lds, const Gemm g, const Sched& S, const Epi& E, unsigned long long* stamps) {
    int tid = threadIdx.x; asm volatile("" : "+v"(tid)); const int wid = __builtin_amdgcn_readfirstlane(tid >> 6), lane = tid & 63, wr = wid >> 2, wc = wid & 3, fr = lane & 15, fq = lane >> 4;
    const int K = g.K, nt = K / BK;
    int ts_lo = 0, ts_hi = 0, nts = 0; const unsigned long long rt_entry = STAMP ? (unsigned long long)wall_clock64() : 0ull;
#define PG8_STAMP() do { if (STAMP && wid == 0 && nts < 64) { const unsigned long long _c = (unsigned long long)clock64(); \
        ts_lo = (lane == nts) ? (int)(unsigned)_c : ts_lo; ts_hi = (lane == nts) ? (int)(unsigned)(_c >> 32) : ts_hi; ++nts; } } while (0)
    PG8_STAMP();
    unsigned voffA[2], voffB[2];
#pragma unroll
    for (int i = 0; i < 2; ++i) { int R, C; stage_rc(tid * 16 + i * 8192, R, C); const int Rb = Epi::PERM ? ((R & ~31) + perm32(R & 31)) : R;
        voffA[i] = (unsigned)(R * K + C) * 2u; voffB[i] = (unsigned)(Rb * K + C) * 2u; }
    const size_t kstep = (size_t)(BK * 2);
    const size_t hstep = (size_t)HALF * K * 2;
    const size_t tstep = 2 * hstep;
    const unsigned ldsw = (unsigned)wid * 1024u;
    const int aoff = lds_byte(wr * 64 + fr, fq * 8), boff = lds_byte(wc * 32 + fr, fq * 8);
#define PG8_SA(b, h) (((b) * 2 + (h)) * HTB)
#define PG8_SB(b, h) ((4 + (b) * 2 + (h)) * HTB)
#define PG8_STAGE(bufoff, gbase, voff) do { _Pragma("unroll") for (int _i = 0; _i < 2; ++_i) \
        __builtin_amdgcn_global_load_lds((const unsigned*)((const char*)(gbase) + (voff)[_i]), (PG8_LAS unsigned*)(lds + (bufoff) + ldsw + _i * 8192), 16, 0, 0); } while (0)
#define PG8_LDA(dst, b, h) do { _Pragma("unroll") for (int m = 0; m < 4; ++m) _Pragma("unroll") for (int k = 0; k < 2; ++k) dst[m][k] = *(const PG8_LAS bf16x8*)(lds + PG8_SA(b, h) + aoff + m * 2048 + k * 1024); } while (0)
#define PG8_LDB(dst, b, h) do { _Pragma("unroll") for (int n = 0; n < 2; ++n) _Pragma("unroll") for (int k = 0; k < 2; ++k) dst[n][k] = *(const PG8_LAS bf16x8*)(lds + PG8_SB(b, h) + boff + n * 2048 + k * 1024); } while (0)
#define PG8_MMA(ai, bj, At, Bt) do { __builtin_amdgcn_s_setprio(1); _Pragma("unroll") for (int m = 0; m < 4; ++m) _Pragma("unroll") for (int n = 0; n < 2; ++n) _Pragma("unroll") for (int k = 0; k < 2; ++k) \
        acc[ai][bj][m][n] = __builtin_amdgcn_mfma_f32_16x16x32_bf16(Bt[n][k], At[m][k], acc[ai][bj][m][n], 0, 0, 0); __builtin_amdgcn_s_setprio(0); } while (0)
#define PG8_WAIT_V(n) asm volatile("s_waitcnt vmcnt(" #n ")" ::: "memory")
#define PG8_WAIT_L(n) asm volatile("s_waitcnt lgkmcnt(" #n ")" ::: "memory")
#define PG8_BAR __builtin_amdgcn_s_barrier()
#define PG8_SCHED __builtin_amdgcn_sched_barrier(0)
    Unit cur, nxt; int ui = 0;
    if (!S.next(0, cur)) return;
    f32x4 acc[2][2][4][2];
#pragma unroll
    for (int a = 0; a < 2; ++a)
#pragma unroll
        for (int b = 0; b < 2; ++b)
#pragma unroll
            for (int m = 0; m < 4; ++m)
#pragma unroll
                for (int n = 0; n < 2; ++n) acc[a][b][m][n] = (f32x4){0.f, 0.f, 0.f, 0.f};
    bf16x8 At[4][2], B0[2][2], B1[2][2];
    const char* cA = (const char*)g.A + (size_t)cur.pm * tstep; const char* cB = (const char*)g.Bt + (size_t)cur.pn * tstep;
    S.a_ready(cur);
    PG8_STAGE(PG8_SB(0, 0), cB, voffB); PG8_STAGE(PG8_SA(0, 0), cA, voffA); PG8_STAGE(PG8_SB(0, 1), cB + hstep, voffB); PG8_STAGE(PG8_SA(0, 1), cA + hstep, voffA);
    if (wr == 1) PG8_BAR;
    PG8_WAIT_V(4); PG8_BAR;
    PG8_STAGE(PG8_SB(1, 0), cB + kstep, voffB); PG8_STAGE(PG8_SA(1, 0), cA + kstep, voffA); PG8_STAGE(PG8_SB(1, 1), cB + hstep + kstep, voffB);
    PG8_WAIT_V(6); PG8_BAR;
    PG8_STAMP();
    for (;;) {
        const bool has_next = S.next(ui + 1, nxt);
        const char* nA = has_next ? (const char*)g.A + (size_t)nxt.pm * tstep : cA; const char* nB = has_next ? (const char*)g.Bt + (size_t)nxt.pn * tstep : cB;
        for (int t = 0; t < nt; t += 2) {
            const bool last = (t == nt - 2);
            const char* a1 = cA + (size_t)(t + 1) * kstep;
            const char* a2 = last ? nA : cA + (size_t)(t + 2) * kstep; const char* b2 = last ? nB : cB + (size_t)(t + 2) * kstep;
            const char* a3 = a2 + kstep; const char* b3 = b2 + kstep;
            if (last && has_next) S.a_ready(nxt);
            PG8_LDB(B0, 0, 0); PG8_SCHED; PG8_LDA(At, 0, 0); PG8_STAGE(PG8_SA(1, 1), a1 + hstep, voffA);
            PG8_WAIT_L(8); PG8_BAR; PG8_WAIT_L(0); PG8_MMA(0, 0, At, B0); PG8_BAR; PG8_SCHED;
            PG8_LDB(B1, 0, 1); PG8_STAGE(PG8_SB(0, 0), b2, voffB);
            PG8_BAR; PG8_WAIT_L(0); PG8_MMA(0, 1, At, B1); PG8_BAR;
            PG8_LDA(At, 0, 1); PG8_STAGE(PG8_SA(0, 0), a2, voffA);
            PG8_BAR; PG8_WAIT_L(0); PG8_MMA(1, 0, At, B0); PG8_BAR; PG8_SCHED;
            PG8_STAGE(PG8_SB(0, 1), b2 + hstep, voffB);
            PG8_WAIT_V(6); PG8_BAR; PG8_MMA(1, 1, At, B1); PG8_BAR;
            PG8_LDB(B0, 1, 0); PG8_SCHED; PG8_LDA(At, 1, 0); PG8_STAGE(PG8_SA(0, 1), a2 + hstep, voffA);
            PG8_WAIT_L(8); PG8_BAR; PG8_WAIT_L(0); PG8_MMA(0, 0, At, B0); PG8_BAR; PG8_SCHED;
            PG8_LDB(B1, 1, 1); PG8_STAGE(PG8_SB(1, 0), b3, voffB);
            PG8_BAR; PG8_WAIT_L(0); PG8_MMA(0, 1, At, B1); PG8_BAR;
            PG8_LDA(At, 1, 1); PG8_STAGE(PG8_SA(1, 0), a3, voffA);
            PG8_BAR; PG8_WAIT_L(0); PG8_MMA(1, 0, At, B0); PG8_BAR; PG8_SCHED;
            PG8_STAGE(PG8_SB(1, 1), b3 + hstep, voffB);
            PG8_WAIT_V(6); PG8_BAR; PG8_MMA(1, 1, At, B1); PG8_BAR;
        }
        PG8_STAMP();
        if constexpr (!Epi::AFTER_DRAIN) { E(acc, cur, wr, wc, fr, fq); S.done(cur); }
        PG8_STAMP();
        if (!has_next) break;
#pragma unroll
        for (int a = 0; a < 2; ++a)
#pragma unroll
            for (int b = 0; b < 2; ++b)
#pragma unroll
                for (int m = 0; m < 4; ++m)
#pragma unroll
                    for (int n = 0; n < 2; ++n) acc[a][b][m][n] = (f32x4){0.f, 0.f, 0.f, 0.f};
        cur = nxt; cA = nA; cB = nB; ++ui;
    }
    PG8_WAIT_V(0);
    if (wr == 0) PG8_BAR;
    PG8_BAR;
    if constexpr (Epi::AFTER_DRAIN) { E.fused(acc, cur, wr, wc, fr, fq, lds, wid, lane); S.done(cur); }
    PG8_STAMP();
    if (STAMP && wid == 0) { stamps[lane] = lane < nts ? (((unsigned long long)(unsigned)ts_hi << 32) | (unsigned)ts_lo) : 0ull;
        if (lane == 62) stamps[62] = rt_entry; if (lane == 63) stamps[63] = (unsigned long long)wall_clock64(); }
#undef PG8_STAMP
#undef PG8_SA
#undef PG8_SB
#undef PG8_STAGE
#undef PG8_LDA
#undef PG8_LDB
#undef PG8_MMA
#undef PG8_WAIT_V
#undef PG8_WAIT_L
#undef PG8_BAR
#undef PG8_SCHED
}
}

__device__ __forceinline__ int map_up(int R) { return ((R >> 7) & 1) * DFF + (R >> 8) * 128 + (R & 127); }
__device__ __forceinline__ int map_in(int R) { return R < 3072 ? R : R - 496; }
__device__ void transpose_tile(LAS unsigned char* lds, const float* src, int ldsrc, bf16_t* dst, int K, int R0, int k0, int kind, const float* wa2) {
    int tid = threadIdx.x; asm volatile("" : "+v"(tid));
    const int r = tid & 63, kq = tid >> 6;
    LAS bf16_t* T = (LAS bf16_t*)lds;
    const int R = R0 + r;
    if (kind == 3) {
        const int j = R - 3072; float wa[16];
#pragma unroll
        for (int q = 0; q < 16; ++q) wa[q] = wa2[q * 512 + j];
#pragma unroll 4
        for (int i = 0; i < 16; ++i) { const int kk = i * 8 + kq; const float* p = src + (size_t)(k0 + kk) * ldsrc + 3072; float s = 0.f;
#pragma unroll
            for (int q = 0; q < 16; ++q) s += p[q] * wa[q];
            T[r * 136 + kk] = (bf16_t)(cvt_pk_bf16(s, 0.f) & 0xffffu); }
    } else {
        const int col = kind == 1 ? map_up(R) : (kind == 2 ? map_in(R) : R);
#pragma unroll 4
        for (int i = 0; i < 16; ++i) { const int kk = i * 8 + kq; const float v = src[(size_t)(k0 + kk) * ldsrc + col]; T[r * 136 + kk] = (bf16_t)(cvt_pk_bf16(v, 0.f) & 0xffffu); }
    }
    __syncthreads();
#pragma unroll
    for (int h = 0; h < 2; ++h) { const int id = tid + h * 512, rr = id >> 4, sg = id & 15;
        const u32x4 v = *(const LAS u32x4*)(lds + rr * 272 + sg * 16);
        *(u32x4*)(dst + (size_t)(R0 + rr) * K + k0 + sg * 8) = v; }
    __syncthreads();
}

struct Args { const float* in[20]; float* out; unsigned char* ws; };
constexpr int CTX_OFF = 139264;
__device__ __forceinline__ unsigned long long ctx_ld(LAS unsigned char* lds, int i) {
    const unsigned long long v = *(volatile LAS unsigned long long*)(lds + CTX_OFF + 8 * i);
    const unsigned lo = __builtin_amdgcn_readfirstlane((unsigned)v), hi = __builtin_amdgcn_readfirstlane((unsigned)(v >> 32));
    return ((unsigned long long)hi << 32) | lo;
}
#define CIN(i) ((const float*)ctx_ld(lds, (i)))
#define COUT   ((float*)ctx_ld(lds, 20))
#define CWS    ((unsigned char*)ctx_ld(lds, 21))

__device__ void prologue(LAS unsigned char* lds) {
    for (int tile = blockIdx.x; tile < 3584 * 4; tile += gridDim.x) {
        const int l = tile / 3584; int r = tile % 3584;
        bf16_t* W = (bf16_t*)(CWS + WS_W) + (size_t)l * W_LAYER;
        if (r < 704) { transpose_tile(lds, CIN(7) + (size_t)l * DM * 2 * DFF, 2 * DFF, W + W_UP1, DM, (r >> 3) * 64, (r & 7) * 128, 1, nullptr); continue; } r -= 704;
        if (r < 352) { transpose_tile(lds, CIN(8) + (size_t)l * DFF * DM, DM, W + W_DN1, DFF, (r / 22) * 64, (r % 22) * 128, 0, nullptr); continue; } r -= 352;
        if (r < 1088) { const int R0 = (r >> 3) * 64; transpose_tile(lds, CIN(9) + (size_t)l * DM * 8208, 8208, W + W_IN, DM, R0, (r & 7) * 128, (R0 >= 3072 && R0 < 3584) ? 3 : 2, CIN(10) + (size_t)l * 16 * 512); continue; } r -= 1088;
        if (r < 128) { transpose_tile(lds, CIN(15) + (size_t)l * DM * DM, DM, W + W_OA, DM, (r >> 3) * 64, (r & 7) * 128, 0, nullptr); continue; } r -= 128;
        if (r < 128) { transpose_tile(lds, CIN(16) + (size_t)l * DM * DM, DM, W + W_OB, DM, (r >> 3) * 64, (r & 7) * 128, 0, nullptr); continue; } r -= 128;
        if (r < 128) { transpose_tile(lds, CIN(17) + (size_t)l * DM * DM, DM, W + W_O, DM, (r >> 3) * 64, (r & 7) * 128, 0, nullptr); continue; } r -= 128;
        if (r < 704) { transpose_tile(lds, CIN(18) + (size_t)l * DM * 2 * DFF, 2 * DFF, W + W_UP2, DM, (r >> 3) * 64, (r & 7) * 128, 1, nullptr); continue; } r -= 704;
        transpose_tile(lds, CIN(19) + (size_t)l * DFF * DM, DM, W + W_DN2, DFF, (r / 22) * 64, (r % 22) * 128, 0, nullptr);
    }
    float* trig = (float*)(CWS + WS_TRIG);
    for (int idx = blockIdx.x * 512 + threadIdx.x; idx < NPOS * 64; idx += gridDim.x * 512) {
        const int pos = idx >> 6, i = idx & 63;
        double inv = 1.0; for (int q = 0; q < i; ++q) inv *= 0.8659643233600653;
        const double rev = (double)pos * inv * 0.15915494309189535; const float fr = (float)(rev - __builtin_rint(rev));
        trig[idx] = __builtin_amdgcn_cosf(fr); trig[NPOS * 64 + idx] = __builtin_amdgcn_sinf(fr);
    }
}

__device__ void init_set(LAS unsigned char* lds, int set, float* h32, bf16_t* hb) {
    const int M = set == 0 ? MSMALL : MBIG;
    const size_t n4 = (size_t)M * DM / 4;
    for (size_t i = (size_t)blockIdx.x * 512 + threadIdx.x; i < n4; i += (size_t)gridDim.x * 512) {
        const size_t row = i >> 8; const int c4 = (int)(i & 255);
        f32x4 v = (f32x4){0.f, 0.f, 0.f, 0.f};
        if (set == 0) { if (row < 256) v = *(const f32x4*)(CIN(1) + row * DM + c4 * 4); else if (row < 272) v = *(const f32x4*)(CIN(4) + (row - 256) * DM + c4 * 4); }
        else v = *(const f32x4*)(CIN(0) + ((size_t)(set - 1) * MBIG + row) * DM + c4 * 4);
        *(f32x4*)(h32 + i * 4) = v;
        u32x2 w; w.x = cvt_pk_bf16(v[0], v[1]); w.y = cvt_pk_bf16(v[2], v[3]); *(u32x2*)(hb + i * 4) = w;
    }
}

__device__ void ln_phase(float* h32, bf16_t* hb, int M, const float* g, const float* b) {
    int tid = threadIdx.x; asm volatile("" : "+v"(tid));
    const int lane = tid & 63, wv = tid >> 6;
    f32x4 gv[4], bv[4];
#pragma unroll
    for (int i = 0; i < 4; ++i) { gv[i] = *(const f32x4*)(g + i * 256 + lane * 4); bv[i] = *(const f32x4*)(b + i * 256 + lane * 4); }
    for (int row = blockIdx.x * 8 + wv; row < M; row += gridDim.x * 8) {
        float* p = h32 + (size_t)row * DM; f32x4 x[4]; float s = 0.f;
#pragma unroll
        for (int i = 0; i < 4; ++i) { x[i] = *(const f32x4*)(p + i * 256 + lane * 4); s += (x[i][0] + x[i][1]) + (x[i][2] + x[i][3]); }
#pragma unroll
        for (int o = 32; o >= 1; o >>= 1) s += __shfl_xor(s, o);
        const float mu = s * (1.0f / 1024.0f); float q = 0.f;
#pragma unroll
        for (int i = 0; i < 4; ++i) { const f32x4 d = x[i] - mu; q += (d[0] * d[0] + d[1] * d[1]) + (d[2] * d[2] + d[3] * d[3]); }
#pragma unroll
        for (int o = 32; o >= 1; o >>= 1) q += __shfl_xor(q, o);
        const float rstd = 1.0f / sqrtf(q * (1.0f / 1024.0f) + LN_EPS_);
#pragma unroll
        for (int i = 0; i < 4; ++i) { const f32x4 y = (x[i] - mu) * rstd * gv[i] + bv[i]; *(f32x4*)(p + i * 256 + lane * 4) = y;
            u32x2 w; w.x = cvt_pk_bf16(y[0], y[1]); w.y = cvt_pk_bf16(y[2], y[3]); *(u32x2*)(hb + (size_t)row * DM + i * 256 + lane * 4) = w; }
    }
}

constexpr int RS128 = 272, RSV = 528, RS64 = 144;
constexpr int L_QE = 0, L_KE = 17408, L_KD = 34816, L_V = 52224, L_ATT = 86016, L_ST = 95232, L_EBL = 132096, L_TOT = 132608, L_RED = 134656;
static_assert(L_RED + 4096 <= LDS_BYTES, "mixer LDS");

__device__ __forceinline__ bf16x8 tr_frag(unsigned addr, int) { return (bf16x8){0,0,0,0,0,0,0,0}; }
__device__ __forceinline__ bf16x8 tr_frag2(unsigned addr, const int off1, const int off2) {
    s16x4 lo, hi;
    asm volatile("ds_read_b64_tr_b16 %0, %2 offset:%3\n\tds_read_b64_tr_b16 %1, %2 offset:%4\n\ts_waitcnt lgkmcnt(0)" : "=&v"(lo), "=&v"(hi) : "v"(addr), "i"(off1), "i"(off2) : "memory");
    return (bf16x8){lo[0], lo[1], lo[2], lo[3], hi[0], hi[1], hi[2], hi[3]};
}
__device__ __forceinline__ void unpack8(const u32x4 w, float (&f)[8]) { f[0] = bf_lo(w.x); f[1] = bf_hi(w.x); f[2] = bf_lo(w.y); f[3] = bf_hi(w.y); f[4] = bf_lo(w.z); f[5] = bf_hi(w.z); f[6] = bf_lo(w.w); f[7] = bf_hi(w.w); }
__device__ __forceinline__ u32x4 pack8(const float (&f)[8]) { u32x4 w; w.x = cvt_pk_bf16(f[0], f[1]); w.y = cvt_pk_bf16(f[2], f[3]); w.z = cvt_pk_bf16(f[4], f[5]); w.w = cvt_pk_bf16(f[6], f[7]); return w; }

struct MixItem { int head, row0, nch, L, pos0; const float* Sin; float* Sout; };

template <bool RET>
__device__ void mixer_item(LAS unsigned char* lds, const MixItem it, const bf16_t* Q, const bf16_t* K, const bf16_t* V, const bf16_t* LG, bf16_t* R,
                           const float* balpha, const float* gn, const float* trig) {
    int tid = threadIdx.x; asm volatile("" : "+v"(tid));
    const int lane = tid & 63, w = __builtin_amdgcn_readfirstlane(tid >> 6), fr = lane & 15, fq = lane >> 4;
    const int tl = tid >> 3, iseg = tid & 7, i0 = iseg * 8;
    const int head = it.head, L = it.L;
    const unsigned ldsb = (unsigned)(size_t)lds;
    const unsigned tr_lane = (unsigned)((8 * fq + ((lane & 15) >> 2)));
    const int tp = lane & 3;
    const unsigned trb_v = ldsb + L_V + tr_lane * RSV + 8 * tp + 64 * w, trb_k = ldsb + L_KD + tr_lane * RS128 + 8 * tp;
    const float scale = 0.08838834764831845f;
    const float lgam = head == 0 ? -0.0317486983145803f : (head == 1 ? -0.015748356968139168f : (head == 2 ? -0.007843177461025893f : -0.003913899321136329f));
    f32x4 S[8][2];
    {
        const float* sp = it.Sin ? it.Sin + (size_t)(4 * fq) * 256 + 32 * w + fr : nullptr;
#pragma unroll
        for (int di = 0; di < 8; ++di) {
            const float* pd = sp + di * 4096; asm volatile("" : "+v"(pd));
#pragma unroll
            for (int ei = 0; ei < 2; ++ei)
#pragma unroll
                for (int j = 0; j < 4; ++j) S[di][ei][j] = sp ? pd[j * 256 + 16 * ei] : 0.f;
        }
    }

    for (int c = 0; c < it.nch; ++c) {
        const size_t row = (size_t)it.row0 + c * 64 + tl; const bool valid = tl < L;
        { u32x4 v0 = (u32x4){0u, 0u, 0u, 0u}, v1 = v0, v2 = v0, v3 = v0;
          if (valid) { const bf16_t* vp = V + row * 1024 + head * 256 + iseg * 32; v0 = *(const u32x4*)vp; v1 = *(const u32x4*)(vp + 8); v2 = *(const u32x4*)(vp + 16); v3 = *(const u32x4*)(vp + 24); }
          LAS unsigned char* vd = lds + L_V + tl * RSV + iseg * 64; *(LAS u32x4*)vd = v0; *(LAS u32x4*)(vd + 16) = v1; *(LAS u32x4*)(vd + 32) = v2; *(LAS u32x4*)(vd + 48) = v3; }
        u32x4 qk[4] = {(u32x4){0u, 0u, 0u, 0u}, (u32x4){0u, 0u, 0u, 0u}, (u32x4){0u, 0u, 0u, 0u}, (u32x4){0u, 0u, 0u, 0u}};
        if (valid) {
            const bf16_t* qp = Q + row * 512 + head * 128 + i0; qk[0] = *(const u32x4*)qp; qk[1] = *(const u32x4*)(qp + 64);
            const bf16_t* kp = K + row * 512 + head * 128 + i0; qk[2] = *(const u32x4*)kp; qk[3] = *(const u32x4*)(kp + 64);
        }
        if (!RET) {
            LAS float* BS = (LAS float*)(lds + L_ST);
#pragma unroll
            for (int h = 0; h < 2; ++h) {
                u32x4 lw = (u32x4){0u, 0u, 0u, 0u};
                if (valid) lw = *(const u32x4*)(LG + row * 512 + head * 128 + 64 * h + i0);
                float lA[8]; unpack8(lw, lA);
                const f32x4 ba0 = *(const f32x4*)(balpha + head * 128 + 64 * h + i0), ba1 = *(const f32x4*)(balpha + head * 128 + 64 * h + i0 + 4);
#pragma unroll
                for (int j = 0; j < 8; ++j) { const float xa = lA[j] + (j < 4 ? ba0[j & 3] : ba1[j & 3]);
                    lA[j] = valid ? (fminf(xa, 0.f) - __logf(1.0f + __expf(-fabsf(xa)))) * 0.0625f : 0.f; }
                *(LAS f32x4*)(BS + tl * 132 + 64 * h + i0) = (f32x4){lA[0], lA[1], lA[2], lA[3]}; *(LAS f32x4*)(BS + tl * 132 + 64 * h + i0 + 4) = (f32x4){lA[4], lA[5], lA[6], lA[7]};
            }
            __syncthreads();
            { const int d = tid & 127, sg = tid >> 7; float run = 0.f;
#pragma unroll
              for (int j = 0; j < 16; ++j) { run += BS[(16 * sg + j) * 132 + d]; BS[(16 * sg + j) * 132 + d] = run; }
              ((LAS float*)(lds + L_TOT))[sg * 128 + d] = run; }
            __syncthreads();
            const LAS float* TOT = (const LAS float*)(lds + L_TOT); const int sgt = tl >> 4;
#pragma unroll
            for (int h = 0; h < 2; ++h) {
                float qh[8], kh[8], oq[8], ok[8], od[8], oe[8]; unpack8(qk[h], qh); unpack8(qk[2 + h], kh);
                const int db = 64 * h + i0;
#pragma unroll
                for (int j = 0; j < 8; ++j) {
                    const float t0 = TOT[db + j], t1 = TOT[128 + db + j], t2 = TOT[256 + db + j], t3 = TOT[384 + db + j];
                    const float ba = BS[tl * 132 + db + j] + (sgt > 0 ? t0 : 0.f) + (sgt > 1 ? t1 : 0.f) + (sgt > 2 ? t2 : 0.f);
                    const float bla = (t0 + t1) + (t2 + t3);
                    oq[j] = qh[j] * __expf(ba) * scale; ok[j] = kh[j] * __expf(-ba); od[j] = kh[j] * __expf(bla - ba); oe[j] = __expf(bla);
                }
                *(LAS u32x4*)(lds + L_QE + tl * RS128 + db * 2) = pack8(oq); *(LAS u32x4*)(lds + L_KE + tl * RS128 + db * 2) = pack8(ok); *(LAS u32x4*)(lds + L_KD + tl * RS128 + db * 2) = pack8(od);
                if (tl == 0) { LAS float* E = (LAS float*)(lds + L_EBL); *(LAS f32x4*)(E + db) = (f32x4){oe[0], oe[1], oe[2], oe[3]}; *(LAS f32x4*)(E + db + 4) = (f32x4){oe[4], oe[5], oe[6], oe[7]}; }
                asm volatile("" ::: "memory");
            }
        } else {
            const int pos = it.pos0 + c * 64 + (valid ? tl : 0);
            const float* cp = trig + (size_t)pos * 64 + i0; const float* sp = cp + NPOS * 64;
            const f32x4 c0 = *(const f32x4*)cp, c1 = *(const f32x4*)(cp + 4), s0 = *(const f32x4*)sp, s1 = *(const f32x4*)(sp + 4);
            const float bt = (float)((tl < L ? tl : L - 1) + 1) * lgam, bl = (float)L * lgam;
            const float eq = __expf(bt), ek = __expf(-bt) * scale, ekd = __expf(bl - bt) * scale, ebl = __expf(bl);
            float qA[8], qB[8], kA[8], kB[8];
            unpack8(qk[0], qA); unpack8(qk[1], qB); unpack8(qk[2], kA); unpack8(qk[3], kB);
#pragma unroll
            for (int j = 0; j < 8; ++j) {
                const float cc = j < 4 ? c0[j & 3] : c1[j & 3], ss = j < 4 ? s0[j & 3] : s1[j & 3];
                const float qa = qA[j] * cc - qB[j] * ss, qb = qB[j] * cc + qA[j] * ss, ka = kA[j] * cc - kB[j] * ss, kb = kB[j] * cc + kA[j] * ss;
                qA[j] = qa; qB[j] = qb; kA[j] = ka; kB[j] = kb;
            }
            { float t[8];
#pragma unroll
              for (int j = 0; j < 8; ++j) t[j] = qA[j] * eq;
              *(LAS u32x4*)(lds + L_QE + tl * RS128 + i0 * 2) = pack8(t);
#pragma unroll
              for (int j = 0; j < 8; ++j) t[j] = qB[j] * eq;
              *(LAS u32x4*)(lds + L_QE + tl * RS128 + (64 + i0) * 2) = pack8(t);
#pragma unroll
              for (int j = 0; j < 8; ++j) t[j] = kA[j] * ek;
              *(LAS u32x4*)(lds + L_KE + tl * RS128 + i0 * 2) = pack8(t);
#pragma unroll
              for (int j = 0; j < 8; ++j) t[j] = kB[j] * ek;
              *(LAS u32x4*)(lds + L_KE + tl * RS128 + (64 + i0) * 2) = pack8(t);
#pragma unroll
              for (int j = 0; j < 8; ++j) t[j] = kA[j] * ekd;
              *(LAS u32x4*)(lds + L_KD + tl * RS128 + i0 * 2) = pack8(t);
#pragma unroll
              for (int j = 0; j < 8; ++j) t[j] = kB[j] * ekd;
              *(LAS u32x4*)(lds + L_KD + tl * RS128 + (64 + i0) * 2) = pack8(t); }
            if (tl == 0) { LAS float* E = (LAS float*)(lds + L_EBL); const f32x4 e4 = (f32x4){ebl, ebl, ebl, ebl};
                *(LAS f32x4*)(E + i0) = e4; *(LAS f32x4*)(E + i0 + 4) = e4; *(LAS f32x4*)(E + 64 + i0) = e4; *(LAS f32x4*)(E + 64 + i0 + 4) = e4; }
        }
        __syncthreads();

#pragma unroll
        for (int q2 = 0; q2 < 2; ++q2) {
            const int idx = 2 * w + q2, si = idx >> 2, ti = idx & 3;
            f32x4 a = (f32x4){0.f, 0.f, 0.f, 0.f};
            if (ti >= si) {
#pragma unroll
                for (int kk = 0; kk < 4; ++kk) {
                    const bf16x8 af = *(const LAS bf16x8*)(lds + L_KE + (16 * si + fr) * RS128 + (32 * kk + 8 * fq) * 2);
                    const bf16x8 bf = *(const LAS bf16x8*)(lds + L_QE + (16 * ti + fr) * RS128 + (32 * kk + 8 * fq) * 2);
                    a = __builtin_amdgcn_mfma_f32_16x16x32_bf16(af, bf, a, 0, 0, 0);
                }
            }
#pragma unroll
            for (int j = 0; j < 4; ++j) if (16 * si + 4 * fq + j > 16 * ti + fr) a[j] = 0.f;
            u32x2 pw; pw.x = cvt_pk_bf16(a[0], a[1]); pw.y = cvt_pk_bf16(a[2], a[3]);
            *(LAS u32x2*)(lds + L_ATT + (16 * ti + fr) * RS64 + (16 * si + 4 * fq) * 2) = pw;
        }
        f32x4 O[2][4];
#pragma unroll
        for (int ei = 0; ei < 2; ++ei)
#pragma unroll
            for (int ti = 0; ti < 4; ++ti) O[ei][ti] = (f32x4){0.f, 0.f, 0.f, 0.f};
        LAS unsigned char* STw = lds + L_ST + w * (32 * RS64);
#pragma unroll
        for (int half = 0; half < 2; ++half) {
#pragma unroll
            for (int d4 = 0; d4 < 4; ++d4)
#pragma unroll
                for (int ei = 0; ei < 2; ++ei) { const f32x4 s = S[4 * half + d4][ei]; u32x2 pw; pw.x = cvt_pk_bf16(s[0], s[1]); pw.y = cvt_pk_bf16(s[2], s[3]);
                    *(LAS u32x2*)(STw + (16 * ei + fr) * RS64 + (16 * d4 + 4 * fq) * 2) = pw; }
            asm volatile("s_waitcnt lgkmcnt(0)" ::: "memory");
#pragma unroll
            for (int kk = 0; kk < 2; ++kk) {
                bf16x8 af[2];
#pragma unroll
                for (int ei = 0; ei < 2; ++ei) af[ei] = *(const LAS bf16x8*)(STw + (16 * ei + fr) * RS64 + (32 * kk + 8 * fq) * 2);
#pragma unroll
                for (int ti = 0; ti < 4; ++ti) { const bf16x8 bf = *(const LAS bf16x8*)(lds + L_QE + (16 * ti + fr) * RS128 + (64 * half + 32 * kk + 8 * fq) * 2);
#pragma unroll
                    for (int ei = 0; ei < 2; ++ei) O[ei][ti] = __builtin_amdgcn_mfma_f32_16x16x32_bf16(af[ei], bf, O[ei][ti], 0, 0, 0); }
            }
            asm volatile("s_waitcnt lgkmcnt(0)" ::: "memory");
        }
        __syncthreads();
        bf16x8 vf[2][2];
#pragma unroll
        for (int ei = 0; ei < 2; ++ei)
#pragma unroll
            for (int kk = 0; kk < 2; ++kk) vf[ei][kk] = tr_frag2(trb_v, 32 * kk * RSV + 32 * ei, 32 * kk * RSV + 32 * ei + 4 * RSV);
#pragma unroll
        for (int kk = 0; kk < 2; ++kk)
#pragma unroll
            for (int ti = 0; ti < 4; ++ti) { const bf16x8 bf = *(const LAS bf16x8*)(lds + L_ATT + (16 * ti + fr) * RS64 + (32 * kk + 8 * fq) * 2);
#pragma unroll
                for (int ei = 0; ei < 2; ++ei) O[ei][ti] = __builtin_amdgcn_mfma_f32_16x16x32_bf16(vf[ei][kk], bf, O[ei][ti], 0, 0, 0); }
        u32x2 rg[2][4];
        bf16_t* Rc = R + ((size_t)it.row0 + c * 64 + fr) * 1024 + head * 256 + 32 * w + 4 * fq; asm volatile("" : "+v"(Rc));
#pragma unroll
        for (int ei = 0; ei < 2; ++ei)
#pragma unroll
            for (int ti = 0; ti < 4; ++ti) { const int t = 16 * ti + fr; rg[ei][ti] = (u32x2){0u, 0u};
                if (t < L) rg[ei][ti] = *(const u32x2*)(Rc + ti * 16384 + 16 * ei); }
#pragma unroll
        for (int di = 0; di < 8; ++di) {
            const f32x4 eb = *(const LAS f32x4*)(lds + L_EBL + (16 * di + 4 * fq) * 4);
#pragma unroll
            for (int ei = 0; ei < 2; ++ei) S[di][ei] = S[di][ei] * eb;
#pragma unroll
            for (int kk = 0; kk < 2; ++kk) { const bf16x8 kf = tr_frag2(trb_k, 32 * kk * RS128 + 32 * di, 32 * kk * RS128 + 32 * di + 4 * RS128);
#pragma unroll
                for (int ei = 0; ei < 2; ++ei) S[di][ei] = __builtin_amdgcn_mfma_f32_16x16x32_bf16(kf, vf[ei][kk], S[di][ei], 0, 0, 0); }
        }
        { LAS f32x2* RED = (LAS f32x2*)(lds + L_RED);
#pragma unroll
          for (int ti = 0; ti < 4; ++ti) { float s1 = 0.f, s2 = 0.f;
#pragma unroll
              for (int ei = 0; ei < 2; ++ei)
#pragma unroll
                  for (int j = 0; j < 4; ++j) { const float x = O[ei][ti][j]; s1 += x; s2 += x * x; }
              s1 += __shfl_xor(s1, 16); s2 += __shfl_xor(s2, 16); s1 += __shfl_xor(s1, 32); s2 += __shfl_xor(s2, 32);
              if (fq == 0) RED[w * 64 + 16 * ti + fr] = (f32x2){s1, s2}; }
          __syncthreads();
#pragma unroll
          for (int ti = 0; ti < 4; ++ti) { const int t = 16 * ti + fr; float s1 = 0.f, s2 = 0.f;
#pragma unroll
              for (int ww = 0; ww < 8; ++ww) { const f32x2 p = RED[ww * 64 + t]; s1 += p.x; s2 += p.y; }
              const float mu = s1 * (1.0f / 256.0f), var = fmaxf(s2 * (1.0f / 256.0f) - mu * mu, 0.f), rstd = 1.0f / sqrtf(var + GN_EPS_);
              if (t < L) {
#pragma unroll
                  for (int ei = 0; ei < 2; ++ei) { const int e = 32 * w + 16 * ei + 4 * fq; const f32x4 g = *(const f32x4*)(gn + head * 256 + e); const f32x4 o = O[ei][ti];
                      const float r0 = bf_lo(rg[ei][ti].x), r1 = bf_hi(rg[ei][ti].x), r2 = bf_lo(rg[ei][ti].y), r3 = bf_hi(rg[ei][ti].y);
                      u32x2 pw; pw.x = cvt_pk_bf16(fast_silu(r0) * ((o[0] - mu) * rstd * g[0]), fast_silu(r1) * ((o[1] - mu) * rstd * g[1]));
                      pw.y = cvt_pk_bf16(fast_silu(r2) * ((o[2] - mu) * rstd * g[2]), fast_silu(r3) * ((o[3] - mu) * rstd * g[3]));
                      *(u32x2*)(Rc + ti * 16384 + 16 * ei) = pw; } }
          } }
    }
    {
        float* sp = it.Sout + (size_t)(4 * fq) * 256 + 32 * w + fr;
#pragma unroll
        for (int di = 0; di < 8; ++di) {
            float* pd = sp + di * 4096; asm volatile("" : "+v"(pd));
#pragma unroll
            for (int ei = 0; ei < 2; ++ei)
#pragma unroll
                for (int j = 0; j < 4; ++j) pd[j * 256 + 16 * ei] = S[di][ei][j];
        }
    }
    __syncthreads();
}

__device__ void mixer_phase(LAS unsigned char* lds, int set, int l, bf16_t* Z, int M) {
    const int nitems = set == 0 ? 72 : 128;
    bf16_t* qg = Z; bf16_t* kg = Z + (size_t)M * 512; bf16_t* vg = Z + (size_t)M * 1024; bf16_t* rgp = Z + (size_t)M * 2048; bf16_t* lgp = Z + (size_t)M * 3072;
    bf16_t* qr = Z + (size_t)M * 3584; bf16_t* kr = Z + (size_t)M * 4096; bf16_t* vr = Z + (size_t)M * 4608; bf16_t* grp = Z + (size_t)M * 5632;
    const float* trig = (const float*)(CWS + WS_TRIG); float* smeta = (float*)(CWS + WS_SMETA);
    for (int itx = blockIdx.x; itx < nitems; itx += gridDim.x) {
        MixItem it; int ret;
        if (set == 0) {
            if (itx < 64) { ret = itx >> 5; const int bh = itx & 31, b = bh >> 2; it.head = bh & 3; it.row0 = b * 32; it.nch = 1; it.L = 32; it.pos0 = 1040;
                const size_t so = ((size_t)(l * 8 + b) * 4 + it.head) * 32768; it.Sin = CIN(ret ? 3 : 2) + so; it.Sout = COUT + (ret ? OUT_RET_S : OUT_GLA_S) + so; }
            else { const int j = itx - 64; ret = j >> 2; it.head = j & 3; it.row0 = 256; it.nch = 1; it.L = 16; it.pos0 = 0; it.Sin = nullptr; it.Sout = smeta + ((size_t)(l * 2 + ret) * 4 + it.head) * 32768; }
        } else {
            ret = itx >> 6; const int bh = itx & 63, b = bh >> 2; it.head = bh & 3; it.row0 = b * 2048; it.nch = 32; it.L = 64; it.pos0 = 16;
            it.Sin = smeta + ((size_t)(l * 2 + ret) * 4 + it.head) * 32768; it.Sout = COUT + (ret ? OUT_RET_P : OUT_GLA_P) + ((size_t)(l * 32 + (set - 1) * 16 + b) * 4 + it.head) * 32768;
        }
        if (ret) mixer_item<true>(lds, it, qr, kr, vr, nullptr, grp, nullptr, CIN(14) + (size_t)l * 1024, trig);
        else mixer_item<false>(lds, it, qg, kg, vg, lgp, rgp, CIN(11) + (size_t)l * 512, CIN(13) + (size_t)l * 1024, trig);
    }
}

#define SET_M   (set == 0 ? MSMALL : MBIG)
#define SET_H   (set == 0 ? COUT + OUT_YS : COUT + OUT_YP + (size_t)(set - 1) * MBIG * DM)
#define P_HB    ((bf16_t*)(CWS + WS_HB))
#define P_Z     ((bf16_t*)(CWS + WS_Z))
#define P_W     ((const bf16_t*)(CWS + WS_W) + (size_t)l * W_LAYER)
#define GEMM(EPI, A_, B_, N_, K_, ...) do { const int M = SET_M; pg8::Gemm g{A_, B_, M, N_, K_}; pg8::StaticOrder S; S.init(M, N_, (int)gridDim.x, (int)blockIdx.x); EPI E{__VA_ARGS__}; pg8::gemm_phase<EPI, pg8::StaticOrder>(lds, g, S, E, nullptr); } while (0)
__global__ void __launch_bounds__(512, 2) fwd_megakernel(Args a, int ph_lo, int ph_hi) {
    extern __shared__ __attribute__((aligned(16))) unsigned char shm[];
    LAS unsigned char* lds = (LAS unsigned char*)shm;
    cg::grid_group grid = cg::this_grid();
    if (threadIdx.x < 20) *(LAS unsigned long long*)(lds + CTX_OFF + 8 * threadIdx.x) = (unsigned long long)a.in[threadIdx.x];
    if (threadIdx.x == 20) *(LAS unsigned long long*)(lds + CTX_OFF + 8 * 20) = (unsigned long long)a.out;
    if (threadIdx.x == 21) *(LAS unsigned long long*)(lds + CTX_OFF + 8 * 21) = (unsigned long long)a.ws;
    __syncthreads();
    int ph = 0;
#define PHASE(...) do { if (ph >= ph_lo && ph < ph_hi) { __VA_ARGS__; if (ph + 1 < ph_hi) grid.sync(); } ++ph; } while (0)
    PHASE(prologue(lds));
    for (int set = 0; set < 3; ++set) {
        PHASE(init_set(lds, set, SET_H, P_HB));
        for (int l = 0; l < DEPTH_; ++l) {
            PHASE(GEMM(pg8::EpiSwiglu, P_HB, P_W + W_UP1, 2 * DFF, DM, P_Z, DFF));
            PHASE(GEMM(pg8::EpiResid, P_Z, P_W + W_DN1, DM, DFF, SET_H, DN_ALPHA_, 0.5f));
            PHASE(ln_phase(SET_H, P_HB, SET_M, CIN(5) + (size_t)l * 3 * DM, CIN(6) + (size_t)l * 3 * DM));
            PHASE(GEMM(pg8::EpiZ, P_HB, P_W + W_IN, NZ, DM, P_Z, M));
            PHASE(mixer_phase(lds, set, l, P_Z, SET_M));
            PHASE(GEMM(pg8::EpiGate<false>, P_Z + (size_t)M * 2048, P_W + W_OA, DM, DM, P_Z + (size_t)M * 6656, CIN(12) + (size_t)l * 2048, 0, nullptr, P_Z + (size_t)M * 1024));
            PHASE(GEMM(pg8::EpiGate<true>, P_Z + (size_t)M * 5632, P_W + W_OB, DM, DM, P_Z + (size_t)M * 6656, CIN(12) + (size_t)l * 2048, 1024, P_Z + (size_t)M * 1024, P_Z + (size_t)M * 4608));
            PHASE(GEMM(pg8::EpiResid, P_Z + (size_t)M * 4608, P_W + W_O, DM, DM, SET_H, DN_ALPHA_, 1.0f));
            PHASE(ln_phase(SET_H, P_HB, SET_M, CIN(5) + (size_t)(l * 3 + 1) * DM, CIN(6) + (size_t)(l * 3 + 1) * DM));
            PHASE(GEMM(pg8::EpiSwiglu, P_HB, P_W + W_UP2, 2 * DFF, DM, P_Z, DFF));
            PHASE(GEMM(pg8::EpiResid, P_Z, P_W + W_DN2, DM, DFF, SET_H, DN_ALPHA_, 0.5f));
            PHASE(ln_phase(SET_H, P_HB, SET_M, CIN(5) + (size_t)(l * 3 + 2) * DM, CIN(6) + (size_t)(l * 3 + 2) * DM));
        }
    }
#undef PHASE
}
constexpr int N_PHASES = 1 + 3 * (1 + 4 * 12);

extern "C" void kernel_launch(void* const* d_in, const int* in_sizes, int n_in, void* d_out, int out_size, void* d_ws, size_t ws_size, hipStream_t stream) {
    static int grid = 0;
    if (grid == 0) {
        int dev = 0, cus = 0, per_cu = 0;
        hipGetDevice(&dev); hipDeviceGetAttribute(&cus, hipDeviceAttributeMultiprocessorCount, dev);
        hipFuncSetAttribute((const void*)fwd_megakernel, hipFuncAttributeMaxDynamicSharedMemorySize, LDS_BYTES);
        hipOccupancyMaxActiveBlocksPerMultiprocessor(&per_cu, (const void*)fwd_megakernel, 512, LDS_BYTES);
        if (per_cu < 1) per_cu = 1;
        grid = cus * (per_cu > 1 ? 1 : per_cu);
        if (ws_size < WS_END) { fprintf(stderr, "kernel_launch: workspace too small: %zu < %zu\n", ws_size, (size_t)WS_END); }
        (void)hipGetLastError();
    }
    Args a{};
    for (int i = 0; i < 20; ++i) a.in[i] = (const float*)d_in[i];
    a.out = (float*)d_out; a.ws = (unsigned char*)d_ws;
    int lo = 0, hi = N_PHASES;
    void* args[] = {&a, &lo, &hi};
    hipError_t e = hipLaunchCooperativeKernel((const void*)fwd_megakernel, dim3(grid), dim3(512), args, LDS_BYTES, stream);
    if (e != hipSuccess) fprintf(stderr, "cooperative launch failed: %s (grid %d)\n", hipGetErrorString(e), grid);
}
```

```cpp
#include <hip/hip_runtime.h>
#include <hip/hip_cooperative_groups.h>
#include <cstdio>
namespace cg = cooperative_groups;

#define LAS __attribute__((address_space(3)))
typedef unsigned short bf16_t;
typedef short bf16x8 __attribute__((ext_vector_type(8)));
typedef short s16x4 __attribute__((ext_vector_type(4)));
typedef float f32x4 __attribute__((ext_vector_type(4)));
typedef float f32x2 __attribute__((ext_vector_type(2)));
typedef unsigned u32x4 __attribute__((ext_vector_type(4)));
typedef unsigned u32x2 __attribute__((ext_vector_type(2)));

constexpr int DM = 1024, DFF = 2816, NZ = 8704, DEPTH_ = 4;
constexpr int MBIG = 32768, MSMALL = 512, NPOS = 2064;
constexpr float DN_ALPHA_ = 1.681792830507429f;
constexpr float LN_EPS_ = 1e-5f, GN_EPS_ = 1e-5f;
constexpr size_t OUT_YP = 0, OUT_YS = 67108864, OUT_GLA_P = 67371008, OUT_RET_P = 84148224, OUT_GLA_S = 100925440, OUT_RET_S = 105119744;
constexpr size_t W_UP1 = 0, W_DN1 = 5767168, W_IN = 8650752, W_OA = 17563648, W_OB = 18612224, W_O = 19660800, W_UP2 = 20709376, W_DN2 = 26476544, W_LAYER = 29360128;
constexpr size_t WS_CTL = 0, WS_TRIG = 65536, WS_SMETA = WS_TRIG + 2097152, WS_W = WS_SMETA + 4194304, WS_HB = WS_W + W_LAYER * 2 * 4,
                 WS_Z = WS_HB + (size_t)MBIG * DM * 2, WS_END = WS_Z + (size_t)MBIG * NZ * 2;
constexpr int LDS_BYTES = 139520;

__device__ __forceinline__ unsigned cvt_pk_bf16(float lo, float hi) { unsigned r; asm volatile("v_cvt_pk_bf16_f32 %0, %1, %2" : "=v"(r) : "v"(lo), "v"(hi)); return r; }
__device__ __forceinline__ float bf_lo(unsigned w) { return __uint_as_float(w << 16); }
__device__ __forceinline__ float bf_hi(unsigned w) { return __uint_as_float(w & 0xffff0000u); }
__device__ __forceinline__ float fast_sigmoid(float x) { return __builtin_amdgcn_rcpf(1.0f + __expf(-x)); }
__device__ __forceinline__ float fast_silu(float x) { return x * fast_sigmoid(x); }

namespace pg8 {
#define PG8_LAS __attribute__((address_space(3)))
typedef unsigned short bf16_t;
typedef short bf16x8 __attribute__((ext_vector_type(8)));
typedef float f32x4 __attribute__((ext_vector_type(4)));
typedef unsigned u32x4 __attribute__((ext_vector_type(4)));
constexpr int BM = 256, BK = 64, HALF = 128, HTB = HALF * BK * 2  , STAGE_BYTES = 8 * HTB, NXCD = 8, WGM = 8;

__host__ __device__ __forceinline__ int lds_byte(int r, int c) { const int st = (r >> 4) * 2 + (c >> 5), rr = r & 15, cc = c & 31, ob = rr * 64 + cc * 2; return st * 1024 + (ob ^ (((ob >> 9) & 1) << 5)); }
__host__ __device__ __forceinline__ void stage_rc(int b, int& R, int& C) { const int st = b / 1024, sb = b % 1024, swz = sb ^ (((sb >> 9) & 1) << 5); R = (st >> 1) * 16 + swz / 64; C = (st & 1) * 32 + (swz % 64) / 2; }
__host__ __device__ __forceinline__ int perm32(int rho) { const int n = rho >> 4, i = rho & 15; return 8 * (i >> 2) + 4 * n + (i & 3); }

struct Unit { int pm, pn; };
struct Gemm { const bf16_t* A; const bf16_t* Bt; int M, N, K; };

struct StaticOrder {
    int nM, nN, nwg, G, c;
    __host__ __device__ void init(int M, int N, int G_, int c_) { nM = M / BM; nN = N / BM; nwg = nM * nN; G = G_; c = c_; }
    __host__ __device__ bool next(int i, Unit& u) const {
        const long L = (long)i * G + c; if (L >= nwg) return false;
        int wgid = (int)L; { const int q = nwg / NXCD, r = nwg % NXCD, xcd = wgid % NXCD, off = wgid / NXCD; wgid = (xcd < r ? xcd * (q + 1) : r * (q + 1) + (xcd - r) * q) + off; }
        const int nig = WGM * nN, gid = wgid / nig, fm = gid * WGM, gsz = (nM - fm) < WGM ? (nM - fm) : WGM;
        u.pm = fm + ((wgid % nig) % gsz); u.pn = (wgid % nig) / gsz; return true;
    }
    __device__ __forceinline__ void a_ready(const Unit&) const {}
    __device__ __forceinline__ void done(const Unit&) const {}
};


struct EpiSwiglu {
    static constexpr bool PERM = true, AFTER_DRAIN = false;
    bf16_t* U; int ldc;
    __device__ __forceinline__ void operator()(const f32x4 (&acc)[2][2][4][2], const Unit& u, int wr, int wc, int fr, int fq) const {
        const int row0 = u.pm * BM + wr * 64 + fr, col0 = u.pn * 128 + wc * 32 + 8 * fq;
#pragma unroll
        for (int ai = 0; ai < 2; ++ai)
#pragma unroll
            for (int m = 0; m < 4; ++m) {
                bf16_t* rowp = U + (size_t)(row0 + ai * HALF + m * 16) * ldc + col0;
                const f32x4 a0 = acc[ai][0][m][0], a1 = acc[ai][0][m][1], b0 = acc[ai][1][m][0], b1 = acc[ai][1][m][1];
                u32x4 w;
                w.x = cvt_pk_bf16(fast_silu(a0[0]) * b0[0], fast_silu(a0[1]) * b0[1]); w.y = cvt_pk_bf16(fast_silu(a0[2]) * b0[2], fast_silu(a0[3]) * b0[3]);
                w.z = cvt_pk_bf16(fast_silu(a1[0]) * b1[0], fast_silu(a1[1]) * b1[1]); w.w = cvt_pk_bf16(fast_silu(a1[2]) * b1[2], fast_silu(a1[3]) * b1[3]);
                *(u32x4*)rowp = w;
            }
    }
};
struct EpiResid {
    static constexpr bool PERM = false, AFTER_DRAIN = false;
    float* H; float alpha, s;
    __device__ __forceinline__ void operator()(const f32x4 (&acc)[2][2][4][2], const Unit& u, int wr, int wc, int fr, int fq) const {
        const int row0 = u.pm * BM + wr * 64 + fr, col0 = u.pn * BM + wc * 32 + 4 * fq;
#pragma unroll
        for (int ai = 0; ai < 2; ++ai)
#pragma unroll
            for (int m = 0; m < 4; ++m) { float* rowp = H + (size_t)(row0 + ai * HALF + m * 16) * DM + col0;
#pragma unroll
                for (int bj = 0; bj < 2; ++bj)
#pragma unroll
                    for (int n = 0; n < 2; ++n) { float* p = rowp + bj * HALF + n * 16; const f32x4 h = *(const f32x4*)p; *(f32x4*)p = h * alpha + acc[ai][bj][m][n] * s; } }
    }
};
struct EpiZ {
    static constexpr bool PERM = true, AFTER_DRAIN = false;
    bf16_t* Z; int M;
    __device__ __forceinline__ void operator()(const f32x4 (&acc)[2][2][4][2], const Unit& u, int wr, int wc, int fr, int fq) const {
        const int pn = u.pn; int ts, cs, wd;
        if (pn < 2) { ts = 0; cs = 0; wd = 512; } else if (pn < 4) { ts = 2; cs = 512; wd = 512; } else if (pn < 8) { ts = 4; cs = 1024; wd = 1024; } else if (pn < 12) { ts = 8; cs = 2048; wd = 1024; }
        else if (pn < 14) { ts = 12; cs = 3072; wd = 512; } else if (pn < 16) { ts = 14; cs = 3584; wd = 512; } else if (pn < 18) { ts = 16; cs = 4096; wd = 512; } else if (pn < 22) { ts = 18; cs = 4608; wd = 1024; }
        else if (pn < 26) { ts = 22; cs = 5632; wd = 1024; } else { ts = 26; cs = 6656; wd = 2048; }
        bf16_t* base = Z + (size_t)M * cs;
        const int row0 = u.pm * BM + wr * 64 + fr, col0 = (pn - ts) * BM + wc * 32 + 8 * fq;
#pragma unroll
        for (int ai = 0; ai < 2; ++ai)
#pragma unroll
            for (int m = 0; m < 4; ++m) { bf16_t* rowp = base + (size_t)(row0 + ai * HALF + m * 16) * wd + col0;
#pragma unroll
                for (int bj = 0; bj < 2; ++bj) { const f32x4 v0 = acc[ai][bj][m][0], v1 = acc[ai][bj][m][1];
                    u32x4 w; w.x = cvt_pk_bf16(v0[0], v0[1]); w.y = cvt_pk_bf16(v0[2], v0[3]); w.z = cvt_pk_bf16(v1[0], v1[1]); w.w = cvt_pk_bf16(v1[2], v1[3]);
                    *(u32x4*)(rowp + bj * HALF) = w; } }
    }
};
template <bool ADD> struct EpiGate {
    static constexpr bool PERM = true, AFTER_DRAIN = false;
    const bf16_t* MG; const float* bm; int goff; const bf16_t* prev; bf16_t* out;
    __device__ __forceinline__ void operator()(const f32x4 (&acc)[2][2][4][2], const Unit& u, int wr, int wc, int fr, int fq) const {
        const int row0 = u.pm * BM + wr * 64 + fr, col0 = u.pn * BM + wc * 32 + 8 * fq;
#pragma unroll
        for (int ai = 0; ai < 2; ++ai)
#pragma unroll
            for (int m = 0; m < 4; ++m) { const size_t row = (size_t)(row0 + ai * HALF + m * 16);
#pragma unroll
                for (int bj = 0; bj < 2; ++bj) { const int c = col0 + bj * HALF;
                    const u32x4 g = *(const u32x4*)(MG + row * 2048 + goff + c);
                    const f32x4 bA = *(const f32x4*)(bm + goff + c), bB = *(const f32x4*)(bm + goff + c + 4);
                    const f32x4 v0 = acc[ai][bj][m][0], v1 = acc[ai][bj][m][1];
                    float r[8];
                    r[0] = fast_sigmoid(bf_lo(g.x) + bA[0]) * v0[0]; r[1] = fast_sigmoid(bf_hi(g.x) + bA[1]) * v0[1];
                    r[2] = fast_sigmoid(bf_lo(g.y) + bA[2]) * v0[2]; r[3] = fast_sigmoid(bf_hi(g.y) + bA[3]) * v0[3];
                    r[4] = fast_sigmoid(bf_lo(g.z) + bB[0]) * v1[0]; r[5] = fast_sigmoid(bf_hi(g.z) + bB[1]) * v1[1];
                    r[6] = fast_sigmoid(bf_lo(g.w) + bB[2]) * v1[2]; r[7] = fast_sigmoid(bf_hi(g.w) + bB[3]) * v1[3];
                    if (ADD) { const u32x4 p = *(const u32x4*)(prev + row * DM + c);
                        r[0] += bf_lo(p.x); r[1] += bf_hi(p.x); r[2] += bf_lo(p.y); r[3] += bf_hi(p.y); r[4] += bf_lo(p.z); r[5] += bf_hi(p.z); r[6] += bf_lo(p.w); r[7] += bf_hi(p.w); }
                    u32x4 w; w.x = cvt_pk_bf16(r[0], r[1]); w.y = cvt_pk_bf16(r[2], r[3]); w.z = cvt_pk_bf16(r[4], r[5]); w.w = cvt_pk_bf16(r[6], r[7]);
                    *(u32x4*)(out + row * DM + c) = w; } }
    }
};

template <class Epi, class Sched, bool STAMP = false>
__device__ __forceinline__ void gemm_phase(PG8_LAS unsigned char* lds, const Gemm g, const Sched& S, const Epi& E, unsigned long long* stamps) {
    int tid = threadIdx.x; asm volatile("" : "+v"(tid)); const int wid = __builtin_amdgcn_readfirstlane(tid >> 6), lane = tid & 63, wr = wid >> 2, wc = wid & 3, fr = lane & 15, fq = lane >> 4;
    const int K = g.K, nt = K / BK;
    int ts_lo = 0, ts_hi = 0, nts = 0; const unsigned long long rt_entry = STAMP ? (unsigned long long)wall_clock64() : 0ull;
#define PG8_STAMP() do { if (STAMP && wid == 0 && nts < 64) { const unsigned long long _c = (unsigned long long)clock64(); \
        ts_lo = (lane == nts) ? (int)(unsigned)_c : ts_lo; ts_hi = (lane == nts) ? (int)(unsigned)(_c >> 32) : ts_hi; ++nts; } } while (0)
    PG8_STAMP();
    unsigned voffA[2], voffB[2];
#pragma unroll
    for (int i = 0; i < 2; ++i) { int R, C; stage_rc(tid * 16 + i * 8192, R, C); const int Rb = Epi::PERM ? ((R & ~31) + perm32(R & 31)) : R;
        voffA[i] = (unsigned)(R * K + C) * 2u; voffB[i] = (unsigned)(Rb * K + C) * 2u; }
    const size_t kstep = (size_t)(BK * 2);
    const size_t hstep = (size_t)HALF * K * 2;
    const size_t tstep = 2 * hstep;
    const unsigned ldsw = (unsigned)wid * 1024u;
    const int aoff = lds_byte(wr * 64 + fr, fq * 8), boff = lds_byte(wc * 32 + fr, fq * 8);
#define PG8_SA(b, h) (((b) * 2 + (h)) * HTB)
#define PG8_SB(b, h) ((4 + (b) * 2 + (h)) * HTB)
#define PG8_STAGE(bufoff, gbase, voff) do { _Pragma("unroll") for (int _i = 0; _i < 2; ++_i) \
        __builtin_amdgcn_global_load_lds((const unsigned*)((const char*)(gbase) + (voff)[_i]), (PG8_LAS unsigned*)(lds + (bufoff) + ldsw + _i * 8192), 16, 0, 0); } while (0)
#define PG8_LDA(dst, b, h) do { _Pragma("unroll") for (int m = 0; m < 4; ++m) _Pragma("unroll") for (int k = 0; k < 2; ++k) dst[m][k] = *(const PG8_LAS bf16x8*)(lds + PG8_SA(b, h) + aoff + m * 2048 + k * 1024); } while (0)
#define PG8_LDB(dst, b, h) do { _Pragma("unroll") for (int n = 0; n < 2; ++n) _Pragma("unroll") for (int k = 0; k < 2; ++k) dst[n][k] = *(const PG8_LAS bf16x8*)(lds + PG8_SB(b, h) + boff + n * 2048 + k * 1024); } while (0)
#define PG8_MMA(ai, bj, At, Bt) do { __builtin_amdgcn_s_setprio(1); _Pragma("unroll") for (int m = 0; m < 4; ++m) _Pragma("unroll") for (int n = 0; n < 2; ++n) _Pragma("unroll") for (int k = 0; k < 2; ++k) \
        acc[ai][bj][m][n] = __builtin_amdgcn_mfma_f32_16x16x32_bf16(Bt[n][k], At[m][k], acc[ai][bj][m][n], 0, 0, 0); __builtin_amdgcn_s_setprio(0); } while (0)
#define PG8_WAIT_V(n) asm volatile("s_waitcnt vmcnt(" #n ")" ::: "memory")
#define PG8_WAIT_L(n) asm volatile("s_waitcnt lgkmcnt(" #n ")" ::: "memory")
#define PG8_BAR __builtin_amdgcn_s_barrier()
#define PG8_SCHED __builtin_amdgcn_sched_barrier(0)
    Unit cur, nxt; int ui = 0;
    if (!S.next(0, cur)) return;
    f32x4 acc[2][2][4][2];
#pragma unroll
    for (int a = 0; a < 2; ++a)
#pragma unroll
        for (int b = 0; b < 2; ++b)
#pragma unroll
            for (int m = 0; m < 4; ++m)
#pragma unroll
                for (int n = 0; n < 2; ++n) acc[a][b][m][n] = (f32x4){0.f, 0.f, 0.f, 0.f};
    bf16x8 At[4][2], B0[2][2], B1[2][2];
    const char* cA = (const char*)g.A + (size_t)cur.pm * tstep; const char* cB = (const char*)g.Bt + (size_t)cur.pn * tstep;
    S.a_ready(cur);
    PG8_STAGE(PG8_SB(0, 0), cB, voffB); PG8_STAGE(PG8_SA(0, 0), cA, voffA); PG8_STAGE(PG8_SB(0, 1), cB + hstep, voffB); PG8_STAGE(PG8_SA(0, 1), cA + hstep, voffA);
    if (wr == 1) PG8_BAR;
    PG8_WAIT_V(4); PG8_BAR;
    PG8_STAGE(PG8_SB(1, 0), cB + kstep, voffB); PG8_STAGE(PG8_SA(1, 0), cA + kstep, voffA); PG8_STAGE(PG8_SB(1, 1), cB + hstep + kstep, voffB);
    PG8_WAIT_V(6); PG8_BAR;
    PG8_STAMP();
    for (;;) {
        const bool has_next = S.next(ui + 1, nxt);
        const char* nA = has_next ? (const char*)g.A + (size_t)nxt.pm * tstep : cA; const char* nB = has_next ? (const char*)g.Bt + (size_t)nxt.pn * tstep : cB;
        for (int t = 0; t < nt; t += 2) {
            const bool last = (t == nt - 2);
            const char* a1 = cA + (size_t)(t + 1) * kstep;
            const char* a2 = last ? nA : cA + (size_t)(t + 2) * kstep; const char* b2 = last ? nB : cB + (size_t)(t + 2) * kstep;
            const char* a3 = a2 + kstep; const char* b3 = b2 + kstep;
            if (last && has_next) S.a_ready(nxt);
            PG8_LDB(B0, 0, 0); PG8_SCHED; PG8_LDA(At, 0, 0); PG8_STAGE(PG8_SA(1, 1), a1 + hstep, voffA);
            PG8_WAIT_L(8); PG8_BAR; PG8_WAIT_L(0); PG8_MMA(0, 0, At, B0); PG8_BAR; PG8_SCHED;
            PG8_LDB(B1, 0, 1); PG8_STAGE(PG8_SB(0, 0), b2, voffB);
            PG8_BAR; PG8_WAIT_L(0); PG8_MMA(0, 1, At, B1); PG8_BAR;
            PG8_LDA(At, 0, 1); PG8_STAGE(PG8_SA(0, 0), a2, voffA);
            PG8_BAR; PG8_WAIT_L(0); PG8_MMA(1, 0, At, B0); PG8_BAR; PG8_SCHED;
            PG8_STAGE(PG8_SB(0, 1), b2 + hstep, voffB);
            PG8_WAIT_V(6); PG8_BAR; PG8_MMA(1, 1, At, B1); PG8_BAR;
            PG8_LDB(B0, 1, 0); PG8_SCHED; PG8_LDA(At, 1, 0); PG8_STAGE(PG8_SA(0, 1), a2 + hstep, voffA);
            PG8_WAIT_L(8); PG8_BAR; PG8_WAIT_L(0); PG8_MMA(0, 0, At, B0); PG8_BAR; PG8_SCHED;
            PG8_LDB(B1, 1, 1); PG8_STAGE(PG8_SB(1, 0), b3, voffB);
            PG8_BAR; PG8_WAIT_L(0); PG8_MMA(0, 1, At, B1); PG8_BAR;
            PG8_LDA(At, 1, 1); PG8_STAGE(PG8_SA(1, 0), a3, voffA);
            PG8_BAR; PG8_WAIT_L(0); PG8_MMA(1, 0, At, B0); PG8_BAR; PG8_SCHED;
            PG8_STAGE(PG8_SB(1, 1), b3 + hstep, voffB);
            PG8_WAIT_V(6); PG8_BAR; PG8_MMA(1, 1, At, B1); PG8_BAR;
        }
        PG8_STAMP();
        if constexpr (!Epi::AFTER_DRAIN) { E(acc, cur, wr, wc, fr, fq); S.done(cur); }
        PG8_STAMP();
        if (!has_next) break;
#pragma unroll
        for (int a = 0; a < 2; ++a)
#pragma unroll
            for (int b = 0; b < 2; ++b)
#pragma unroll
                for (int m = 0; m < 4; ++m)
#pragma unroll
                    for (int n = 0; n < 2; ++n) acc[a][b][m][n] = (f32x4){0.f, 0.f, 0.f, 0.f};
        cur = nxt; cA = nA; cB = nB; ++ui;
    }
    PG8_WAIT_V(0);
    if (wr == 0) PG8_BAR;
    PG8_BAR;
    if constexpr (Epi::AFTER_DRAIN) { E.fused(acc, cur, wr, wc, fr, fq, lds, wid, lane); S.done(cur); }
    PG8_STAMP();
    if (STAMP && wid == 0) { stamps[lane] = lane < nts ? (((unsigned long long)(unsigned)ts_hi << 32) | (unsigned)ts_lo) : 0ull;
        if (lane == 62) stamps[62] = rt_entry; if (lane == 63) stamps[63] = (unsigned long long)wall_clock64(); }
#undef PG8_STAMP
#undef PG8_SA
#undef PG8_SB
#undef PG8_STAGE
#undef PG8_LDA
#undef PG8_LDB
#undef PG8_MMA
#undef PG8_WAIT_V
#undef PG8_WAIT_L
#undef PG8_BAR
#undef PG8_SCHED
}
}
#define XB_TMO      128
#define XB_XCNT(j)  (256  + 64 * (j))
#define XB_XSUB(j)  (1280 + 64 * (j))
#define XB_XGEN(j)  (2304 + 64 * (j))
#define XB_TOP      3328
#define XB_TOPGEN   3392
#define XCD_BAR_WORDS 3456
#define XB_SPIN_CAP (1u << 18)

__device__ __forceinline__ unsigned xb_ld(unsigned* p)              { return __hip_atomic_load(p, __ATOMIC_RELAXED, __HIP_MEMORY_SCOPE_AGENT); }
__device__ __forceinline__ unsigned xb_add(unsigned* p, unsigned v) { return __hip_atomic_fetch_add(p, v, __ATOMIC_RELAXED, __HIP_MEMORY_SCOPE_AGENT); }
__device__ __forceinline__ unsigned xb_xcc_id() { return (unsigned)__builtin_amdgcn_s_getreg((3 << 11) | 20) & 0xFu; }
#define XB_SPIN(cond, bar) do { unsigned _sp = 0; while (cond) { __builtin_amdgcn_s_sleep(1); \
    if ((++_sp & 255u) == 0u) { if (xb_ld(&(bar)[XB_TMO])) break; if (_sp > XB_SPIN_CAP) { atomicAdd(&(bar)[XB_TMO], 1u); break; } } } } while (0)

struct XcdBarrier {
    unsigned* bar; unsigned x;
    volatile LAS unsigned* st;
};

__device__ __forceinline__ XcdBarrier xcd_barrier_post(unsigned* bar, volatile LAS unsigned* st) {
    XcdBarrier b; b.bar = bar; b.x = xb_xcc_id(); b.st = st;
    if (threadIdx.x == 0) (void)xb_add(&bar[XB_XCNT(b.x)], 1u);
    return b;
}
__device__ __forceinline__ void xcd_barrier_complete(unsigned* bar, unsigned x, unsigned& nloc, unsigned& nx) {
    const unsigned G = gridDim.x * gridDim.y * gridDim.z;
    unsigned sum, cnt, mine, sp = 0u;
    for (;;) {
        sum = 0u; cnt = 0u; mine = 0u;
#pragma unroll
        for (unsigned j = 0; j < 16; ++j) { const unsigned c = xb_ld(&bar[XB_XCNT(j)]); sum += c; cnt += (c > 0u) ? 1u : 0u; mine = (j == x) ? c : mine; }
        if (sum == G) break;
        __builtin_amdgcn_s_sleep(1);
        if ((++sp & 255u) == 0u) { if (xb_ld(&bar[XB_TMO])) break; if (sp > XB_SPIN_CAP) { atomicAdd(&bar[XB_TMO], 1u); break; } }
    }
    nloc = mine > 0u ? mine : 1u; nx = cnt > 0u ? cnt : 1u;
}

__device__ __forceinline__ void xcd_barrier(const XcdBarrier& b) {
    asm volatile("s_waitcnt vmcnt(0)" ::: "memory");
    __syncthreads();
    if (threadIdx.x == 0) {
        unsigned* bar = b.bar;
        __builtin_amdgcn_s_waitcnt(0);
        unsigned nloc = b.st[0], nx = b.st[1];
        if (nloc == 0u) { xcd_barrier_complete(bar, b.x, nloc, nx); b.st[0] = nloc; b.st[1] = nx; }
        const unsigned old = xb_add(&bar[XB_XSUB(b.x)], 1u);
        const unsigned gen = old / nloc;
        if (old + 1u == (gen + 1u) * nloc) {
            __builtin_amdgcn_fence(__ATOMIC_RELEASE, "agent");
            asm volatile("s_waitcnt vmcnt(0)" ::: "memory");
            const unsigned og = xb_add(&bar[XB_TOP], 1u);
            const unsigned tg = og / nx;
            if (og + 1u == (tg + 1u) * nx) xb_add(&bar[XB_TOPGEN], 1u);
            else XB_SPIN(xb_ld(&bar[XB_TOPGEN]) == tg, bar);
            __builtin_amdgcn_fence(__ATOMIC_ACQUIRE, "agent");
            xb_add(&bar[XB_XGEN(b.x)], 1u);
            asm volatile("s_waitcnt vmcnt(0)" ::: "memory");
        } else {
            XB_SPIN(xb_ld(&bar[XB_XGEN(b.x)]) == gen, bar);
            __builtin_amdgcn_fence(__ATOMIC_ACQUIRE, "agent");
            asm volatile("s_waitcnt vmcnt(0)" ::: "memory");
        }
    }
    __syncthreads();
}


__device__ __forceinline__ int map_up(int R) { return ((R >> 7) & 1) * DFF + (R >> 8) * 128 + (R & 127); }
__device__ __forceinline__ int map_in(int R) { return R < 3072 ? R : R - 496; }
__device__ __forceinline__ void transpose_tile(LAS unsigned char* lds, const float* src, int ldsrc, bf16_t* dst, int K, int R0, int k0, int kind, const float* wa2) {
    int tid = threadIdx.x; asm volatile("" : "+v"(tid));
    const int r = tid & 63, kq = tid >> 6;
    LAS bf16_t* T = (LAS bf16_t*)lds;
    const int R = R0 + r;
    if (kind == 3) {
        const int j = R - 3072; float wa[16];
#pragma unroll
        for (int q = 0; q < 16; ++q) wa[q] = wa2[q * 512 + j];
#pragma unroll 4
        for (int i = 0; i < 16; ++i) { const int kk = i * 8 + kq; const float* p = src + (size_t)(k0 + kk) * ldsrc + 3072; float s = 0.f;
#pragma unroll
            for (int q = 0; q < 16; ++q) s += p[q] * wa[q];
            T[r * 136 + kk] = (bf16_t)(cvt_pk_bf16(s, 0.f) & 0xffffu); }
    } else {
        const int col = kind == 1 ? map_up(R) : (kind == 2 ? map_in(R) : R);
#pragma unroll 4
        for (int i = 0; i < 16; ++i) { const int kk = i * 8 + kq; const float v = src[(size_t)(k0 + kk) * ldsrc + col]; T[r * 136 + kk] = (bf16_t)(cvt_pk_bf16(v, 0.f) & 0xffffu); }
    }
    __syncthreads();
#pragma unroll
    for (int h = 0; h < 2; ++h) { const int id = tid + h * 512, rr = id >> 4, sg = id & 15;
        const u32x4 v = *(const LAS u32x4*)(lds + rr * 272 + sg * 16);
        *(u32x4*)(dst + (size_t)(R0 + rr) * K + k0 + sg * 8) = v; }
    __syncthreads();
}

struct Args { const float* in[20]; float* out; unsigned char* ws; };
constexpr int CTX_OFF = 139264;
__device__ __forceinline__ unsigned long long ctx_ld(LAS unsigned char* lds, int i) {
    const unsigned long long v = *(volatile LAS unsigned long long*)(lds + CTX_OFF + 8 * i);
    const unsigned lo = __builtin_amdgcn_readfirstlane((unsigned)v), hi = __builtin_amdgcn_readfirstlane((unsigned)(v >> 32));
    return ((unsigned long long)hi << 32) | lo;
}
#define CIN(i) ((const float*)ctx_ld(lds, (i)))
#define COUT   ((float*)ctx_ld(lds, 20))
#define CWS    ((unsigned char*)ctx_ld(lds, 21))

__device__ __forceinline__ void prologue(LAS unsigned char* lds) {
    for (int tile = blockIdx.x; tile < 3584 * 4; tile += gridDim.x) {
        const int l = tile / 3584; int r = tile % 3584;
        bf16_t* W = (bf16_t*)(CWS + WS_W) + (size_t)l * W_LAYER;
        if (r < 704) { transpose_tile(lds, CIN(7) + (size_t)l * DM * 2 * DFF, 2 * DFF, W + W_UP1, DM, (r >> 3) * 64, (r & 7) * 128, 1, nullptr); continue; } r -= 704;
        if (r < 352) { transpose_tile(lds, CIN(8) + (size_t)l * DFF * DM, DM, W + W_DN1, DFF, (r / 22) * 64, (r % 22) * 128, 0, nullptr); continue; } r -= 352;
        if (r < 1088) { const int R0 = (r >> 3) * 64; transpose_tile(lds, CIN(9) + (size_t)l * DM * 8208, 8208, W + W_IN, DM, R0, (r & 7) * 128, (R0 >= 3072 && R0 < 3584) ? 3 : 2, CIN(10) + (size_t)l * 16 * 512); continue; } r -= 1088;
        if (r < 128) { transpose_tile(lds, CIN(15) + (size_t)l * DM * DM, DM, W + W_OA, DM, (r >> 3) * 64, (r & 7) * 128, 0, nullptr); continue; } r -= 128;
        if (r < 128) { transpose_tile(lds, CIN(16) + (size_t)l * DM * DM, DM, W + W_OB, DM, (r >> 3) * 64, (r & 7) * 128, 0, nullptr); continue; } r -= 128;
        if (r < 128) { transpose_tile(lds, CIN(17) + (size_t)l * DM * DM, DM, W + W_O, DM, (r >> 3) * 64, (r & 7) * 128, 0, nullptr); continue; } r -= 128;
        if (r < 704) { transpose_tile(lds, CIN(18) + (size_t)l * DM * 2 * DFF, 2 * DFF, W + W_UP2, DM, (r >> 3) * 64, (r & 7) * 128, 1, nullptr); continue; } r -= 704;
        transpose_tile(lds, CIN(19) + (size_t)l * DFF * DM, DM, W + W_DN2, DFF, (r / 22) * 64, (r % 22) * 128, 0, nullptr);
    }
    float* trig = (float*)(CWS + WS_TRIG);
    for (int idx = blockIdx.x * 512 + threadIdx.x; idx < NPOS * 64; idx += gridDim.x * 512) {
        const int pos = idx >> 6, i = idx & 63;
        double inv = 1.0; for (int q = 0; q < i; ++q) inv *= 0.8659643233600653;
        const double rev = (double)pos * inv * 0.15915494309189535; const float fr = (float)(rev - __builtin_rint(rev));
        trig[idx] = __builtin_amdgcn_cosf(fr); trig[NPOS * 64 + idx] = __builtin_amdgcn_sinf(fr);
    }
}

__device__ __forceinline__ void init_set(LAS unsigned char* lds, int set, float* h32, bf16_t* hb) {
    const int M = set == 0 ? MSMALL : MBIG;
    const size_t n4 = (size_t)M * DM / 4;
    for (size_t i = (size_t)blockIdx.x * 512 + threadIdx.x; i < n4; i += (size_t)gridDim.x * 512) {
        const size_t row = i >> 8; const int c4 = (int)(i & 255);
        f32x4 v = (f32x4){0.f, 0.f, 0.f, 0.f};
        if (set == 0) { if (row < 256) v = *(const f32x4*)(CIN(1) + row * DM + c4 * 4); else if (row < 272) v = *(const f32x4*)(CIN(4) + (row - 256) * DM + c4 * 4); }
        else v = *(const f32x4*)(CIN(0) + ((size_t)(set - 1) * MBIG + row) * DM + c4 * 4);
        *(f32x4*)(h32 + i * 4) = v;
        u32x2 w; w.x = cvt_pk_bf16(v[0], v[1]); w.y = cvt_pk_bf16(v[2], v[3]); *(u32x2*)(hb + i * 4) = w;
    }
}

__device__ __forceinline__ void ln_phase(float* h32, bf16_t* hb, int M, const float* g, const float* b) {
    int tid = threadIdx.x; asm volatile("" : "+v"(tid));
    const int lane = tid & 63, wv = tid >> 6;
    f32x4 gv[4], bv[4];
#pragma unroll
    for (int i = 0; i < 4; ++i) { gv[i] = *(const f32x4*)(g + i * 256 + lane * 4); bv[i] = *(const f32x4*)(b + i * 256 + lane * 4); }
    for (int row = blockIdx.x * 8 + wv; row < M; row += gridDim.x * 8) {
        float* p = h32 + (size_t)row * DM; f32x4 x[4]; float s = 0.f;
#pragma unroll
        for (int i = 0; i < 4; ++i) { x[i] = *(const f32x4*)(p + i * 256 + lane * 4); s += (x[i][0] + x[i][1]) + (x[i][2] + x[i][3]); }
#pragma unroll
        for (int o = 32; o >= 1; o >>= 1) s += __shfl_xor(s, o);
        const float mu = s * (1.0f / 1024.0f); float q = 0.f;
#pragma unroll
        for (int i = 0; i < 4; ++i) { const f32x4 d = x[i] - mu; q += (d[0] * d[0] + d[1] * d[1]) + (d[2] * d[2] + d[3] * d[3]); }
#pragma unroll
        for (int o = 32; o >= 1; o >>= 1) q += __shfl_xor(q, o);
        const float rstd = 1.0f / sqrtf(q * (1.0f / 1024.0f) + LN_EPS_);
#pragma unroll
        for (int i = 0; i < 4; ++i) { const f32x4 y = (x[i] - mu) * rstd * gv[i] + bv[i]; *(f32x4*)(p + i * 256 + lane * 4) = y;
            u32x2 w; w.x = cvt_pk_bf16(y[0], y[1]); w.y = cvt_pk_bf16(y[2], y[3]); *(u32x2*)(hb + (size_t)row * DM + i * 256 + lane * 4) = w; }
    }
}

constexpr int RS128 = 272, RSV = 528, RS64 = 144;
constexpr int L_QE = 0, L_KE = 17408, L_KD = 34816, L_V = 52224, L_ATT = 86016, L_ST = 95232, L_EBL = 132096, L_TOT = 132608, L_RED = 134656;
static_assert(L_RED + 4096 <= LDS_BYTES, "mixer LDS");

__device__ __forceinline__ bf16x8 tr_frag(unsigned addr, int) { return (bf16x8){0,0,0,0,0,0,0,0}; }
__device__ __forceinline__ bf16x8 tr_frag2(unsigned addr, const int off1, const int off2) {
    s16x4 lo, hi;
    asm volatile("ds_read_b64_tr_b16 %0, %2 offset:%3\n\tds_read_b64_tr_b16 %1, %2 offset:%4\n\ts_waitcnt lgkmcnt(0)" : "=&v"(lo), "=&v"(hi) : "v"(addr), "i"(off1), "i"(off2) : "memory");
    return (bf16x8){lo[0], lo[1], lo[2], lo[3], hi[0], hi[1], hi[2], hi[3]};
}
__device__ __forceinline__ void unpack8(const u32x4 w, float (&f)[8]) { f[0] = bf_lo(w.x); f[1] = bf_hi(w.x); f[2] = bf_lo(w.y); f[3] = bf_hi(w.y); f[4] = bf_lo(w.z); f[5] = bf_hi(w.z); f[6] = bf_lo(w.w); f[7] = bf_hi(w.w); }
__device__ __forceinline__ u32x4 pack8(const float (&f)[8]) { u32x4 w; w.x = cvt_pk_bf16(f[0], f[1]); w.y = cvt_pk_bf16(f[2], f[3]); w.z = cvt_pk_bf16(f[4], f[5]); w.w = cvt_pk_bf16(f[6], f[7]); return w; }

struct MixItem { int head, row0, nch, L, pos0; const float* Sin; float* Sout; };

template <bool RET>
__device__ __forceinline__ void mixer_item(LAS unsigned char* lds, const MixItem it, const bf16_t* Q, const bf16_t* K, const bf16_t* V, const bf16_t* LG, bf16_t* R,
                           const float* balpha, const float* gn, const float* trig) {
    int tid = threadIdx.x; asm volatile("" : "+v"(tid));
    const int lane = tid & 63, w = __builtin_amdgcn_readfirstlane(tid >> 6), fr = lane & 15, fq = lane >> 4;
    const int tl = tid >> 3, iseg = tid & 7, i0 = iseg * 8;
    const int head = it.head, L = it.L;
    const unsigned ldsb = (unsigned)(size_t)lds;
    const unsigned tr_lane = (unsigned)((8 * fq + ((lane & 15) >> 2)));
    const int tp = lane & 3;
    const unsigned trb_v = ldsb + L_V + tr_lane * RSV + 8 * tp + 64 * w, trb_k = ldsb + L_KD + tr_lane * RS128 + 8 * tp;
    const float scale = 0.08838834764831845f;
    const float lgam = head == 0 ? -0.0317486983145803f : (head == 1 ? -0.015748356968139168f : (head == 2 ? -0.007843177461025893f : -0.003913899321136329f));
    f32x4 S[8][2];
    {
        const float* sp = it.Sin ? it.Sin + (size_t)(4 * fq) * 256 + 32 * w + fr : nullptr;
#pragma unroll
        for (int di = 0; di < 8; ++di) {
            const float* pd = sp + di * 4096; asm volatile("" : "+v"(pd));
#pragma unroll
            for (int ei = 0; ei < 2; ++ei)
#pragma unroll
                for (int j = 0; j < 4; ++j) S[di][ei][j] = sp ? pd[j * 256 + 16 * ei] : 0.f;
        }
    }

    for (int c = 0; c < it.nch; ++c) {
        const size_t row = (size_t)it.row0 + c * 64 + tl; const bool valid = tl < L;
        { u32x4 v0 = (u32x4){0u, 0u, 0u, 0u}, v1 = v0, v2 = v0, v3 = v0;
          if (valid) { const bf16_t* vp = V + row * 1024 + head * 256 + iseg * 32; v0 = *(const u32x4*)vp; v1 = *(const u32x4*)(vp + 8); v2 = *(const u32x4*)(vp + 16); v3 = *(const u32x4*)(vp + 24); }
          LAS unsigned char* vd = lds + L_V + tl * RSV + iseg * 64; *(LAS u32x4*)vd = v0; *(LAS u32x4*)(vd + 16) = v1; *(LAS u32x4*)(vd + 32) = v2; *(LAS u32x4*)(vd + 48) = v3; }
        u32x4 qk[4] = {(u32x4){0u, 0u, 0u, 0u}, (u32x4){0u, 0u, 0u, 0u}, (u32x4){0u, 0u, 0u, 0u}, (u32x4){0u, 0u, 0u, 0u}};
        if (valid) {
            const bf16_t* qp = Q + row * 512 + head * 128 + i0; qk[0] = *(const u32x4*)qp; qk[1] = *(const u32x4*)(qp + 64);
            const bf16_t* kp = K + row * 512 + head * 128 + i0; qk[2] = *(const u32x4*)kp; qk[3] = *(const u32x4*)(kp + 64);
        }
        if (!RET) {
            LAS float* BS = (LAS float*)(lds + L_ST);
#pragma unroll
            for (int h = 0; h < 2; ++h) {
                u32x4 lw = (u32x4){0u, 0u, 0u, 0u};
                if (valid) lw = *(const u32x4*)(LG + row * 512 + head * 128 + 64 * h + i0);
                float lA[8]; unpack8(lw, lA);
                const f32x4 ba0 = *(const f32x4*)(balpha + head * 128 + 64 * h + i0), ba1 = *(const f32x4*)(balpha + head * 128 + 64 * h + i0 + 4);
#pragma unroll
                for (int j = 0; j < 8; ++j) { const float xa = lA[j] + (j < 4 ? ba0[j & 3] : ba1[j & 3]);
                    lA[j] = valid ? (fminf(xa, 0.f) - __logf(1.0f + __expf(-fabsf(xa)))) * 0.0625f : 0.f; }
                *(LAS f32x4*)(BS + tl * 132 + 64 * h + i0) = (f32x4){lA[0], lA[1], lA[2], lA[3]}; *(LAS f32x4*)(BS + tl * 132 + 64 * h + i0 + 4) = (f32x4){lA[4], lA[5], lA[6], lA[7]};
            }
            __syncthreads();
            { const int d = tid & 127, sg = tid >> 7; float run = 0.f;
#pragma unroll
              for (int j = 0; j < 16; ++j) { run += BS[(16 * sg + j) * 132 + d]; BS[(16 * sg + j) * 132 + d] = run; }
              ((LAS float*)(lds + L_TOT))[sg * 128 + d] = run; }
            __syncthreads();
            const LAS float* TOT = (const LAS float*)(lds + L_TOT); const int sgt = tl >> 4;
#pragma unroll
            for (int h = 0; h < 2; ++h) {
                float qh[8], kh[8], oq[8], ok[8], od[8], oe[8]; unpack8(qk[h], qh); unpack8(qk[2 + h], kh);
                const int db = 64 * h + i0;
#pragma unroll
                for (int j = 0; j < 8; ++j) {
                    const float t0 = TOT[db + j], t1 = TOT[128 + db + j], t2 = TOT[256 + db + j], t3 = TOT[384 + db + j];
                    const float ba = BS[tl * 132 + db + j] + (sgt > 0 ? t0 : 0.f) + (sgt > 1 ? t1 : 0.f) + (sgt > 2 ? t2 : 0.f);
                    const float bla = (t0 + t1) + (t2 + t3);
                    oq[j] = qh[j] * __expf(ba) * scale; ok[j] = kh[j] * __expf(-ba); od[j] = kh[j] * __expf(bla - ba); oe[j] = __expf(bla);
                }
                *(LAS u32x4*)(lds + L_QE + tl * RS128 + db * 2) = pack8(oq); *(LAS u32x4*)(lds + L_KE + tl * RS128 + db * 2) = pack8(ok); *(LAS u32x4*)(lds + L_KD + tl * RS128 + db * 2) = pack8(od);
                if (tl == 0) { LAS float* E = (LAS float*)(lds + L_EBL); *(LAS f32x4*)(E + db) = (f32x4){oe[0], oe[1], oe[2], oe[3]}; *(LAS f32x4*)(E + db + 4) = (f32x4){oe[4], oe[5], oe[6], oe[7]}; }
                asm volatile("" ::: "memory");
            }
        } else {
            const int pos = it.pos0 + c * 64 + (valid ? tl : 0);
            const float* cp = trig + (size_t)pos * 64 + i0; const float* sp = cp + NPOS * 64;
            const f32x4 c0 = *(const f32x4*)cp, c1 = *(const f32x4*)(cp + 4), s0 = *(const f32x4*)sp, s1 = *(const f32x4*)(sp + 4);
            const float bt = (float)((tl < L ? tl : L - 1) + 1) * lgam, bl = (float)L * lgam;
            const float eq = __expf(bt), ek = __expf(-bt) * scale, ekd = __expf(bl - bt) * scale, ebl = __expf(bl);
            float qA[8], qB[8], kA[8], kB[8];
            unpack8(qk[0], qA); unpack8(qk[1], qB); unpack8(qk[2], kA); unpack8(qk[3], kB);
#pragma unroll
            for (int j = 0; j < 8; ++j) {
                const float cc = j < 4 ? c0[j & 3] : c1[j & 3], ss = j < 4 ? s0[j & 3] : s1[j & 3];
                const float qa = qA[j] * cc - qB[j] * ss, qb = qB[j] * cc + qA[j] * ss, ka = kA[j] * cc - kB[j] * ss, kb = kB[j] * cc + kA[j] * ss;
                qA[j] = qa; qB[j] = qb; kA[j] = ka; kB[j] = kb;
            }
            { float t[8];
#pragma unroll
              for (int j = 0; j < 8; ++j) t[j] = qA[j] * eq;
              *(LAS u32x4*)(lds + L_QE + tl * RS128 + i0 * 2) = pack8(t);
#pragma unroll
              for (int j = 0; j < 8; ++j) t[j] = qB[j] * eq;
              *(LAS u32x4*)(lds + L_QE + tl * RS128 + (64 + i0) * 2) = pack8(t);
#pragma unroll
              for (int j = 0; j < 8; ++j) t[j] = kA[j] * ek;
              *(LAS u32x4*)(lds + L_KE + tl * RS128 + i0 * 2) = pack8(t);
#pragma unroll
              for (int j = 0; j < 8; ++j) t[j] = kB[j] * ek;
              *(LAS u32x4*)(lds + L_KE + tl * RS128 + (64 + i0) * 2) = pack8(t);
#pragma unroll
              for (int j = 0; j < 8; ++j) t[j] = kA[j] * ekd;
              *(LAS u32x4*)(lds + L_KD + tl * RS128 + i0 * 2) = pack8(t);
#pragma unroll
              for (int j = 0; j < 8; ++j) t[j] = kB[j] * ekd;
              *(LAS u32x4*)(lds + L_KD + tl * RS128 + (64 + i0) * 2) = pack8(t); }
            if (tl == 0) { LAS float* E = (LAS float*)(lds + L_EBL); const f32x4 e4 = (f32x4){ebl, ebl, ebl, ebl};
                *(LAS f32x4*)(E + i0) = e4; *(LAS f32x4*)(E + i0 + 4) = e4; *(LAS f32x4*)(E + 64 + i0) = e4; *(LAS f32x4*)(E + 64 + i0 + 4) = e4; }
        }
        __syncthreads();

#pragma unroll
        for (int q2 = 0; q2 < 2; ++q2) {
            const int idx = 2 * w + q2, si = idx >> 2, ti = idx & 3;
            f32x4 a = (f32x4){0.f, 0.f, 0.f, 0.f};
            if (ti >= si) {
#pragma unroll
                for (int kk = 0; kk < 4; ++kk) {
                    const bf16x8 af = *(const LAS bf16x8*)(lds + L_KE + (16 * si + fr) * RS128 + (32 * kk + 8 * fq) * 2);
                    const bf16x8 bf = *(const LAS bf16x8*)(lds + L_QE + (16 * ti + fr) * RS128 + (32 * kk + 8 * fq) * 2);
                    a = __builtin_amdgcn_mfma_f32_16x16x32_bf16(af, bf, a, 0, 0, 0);
                }
            }
#pragma unroll
            for (int j = 0; j < 4; ++j) if (16 * si + 4 * fq + j > 16 * ti + fr) a[j] = 0.f;
            u32x2 pw; pw.x = cvt_pk_bf16(a[0], a[1]); pw.y = cvt_pk_bf16(a[2], a[3]);
            *(LAS u32x2*)(lds + L_ATT + (16 * ti + fr) * RS64 + (16 * si + 4 * fq) * 2) = pw;
        }
        f32x4 O[2][4];
#pragma unroll
        for (int ei = 0; ei < 2; ++ei)
#pragma unroll
            for (int ti = 0; ti < 4; ++ti) O[ei][ti] = (f32x4){0.f, 0.f, 0.f, 0.f};
        LAS unsigned char* STw = lds + L_ST + w * (32 * RS64);
#pragma unroll
        for (int half = 0; half < 2; ++half) {
#pragma unroll
            for (int d4 = 0; d4 < 4; ++d4)
#pragma unroll
                for (int ei = 0; ei < 2; ++ei) { const f32x4 s = S[4 * half + d4][ei]; u32x2 pw; pw.x = cvt_pk_bf16(s[0], s[1]); pw.y = cvt_pk_bf16(s[2], s[3]);
                    *(LAS u32x2*)(STw + (16 * ei + fr) * RS64 + (16 * d4 + 4 * fq) * 2) = pw; }
            asm volatile("s_waitcnt lgkmcnt(0)" ::: "memory");
#pragma unroll
            for (int kk = 0; kk < 2; ++kk) {
                bf16x8 af[2];
#pragma unroll
                for (int ei = 0; ei < 2; ++ei) af[ei] = *(const LAS bf16x8*)(STw + (16 * ei + fr) * RS64 + (32 * kk + 8 * fq) * 2);
#pragma unroll
                for (int ti = 0; ti < 4; ++ti) { const bf16x8 bf = *(const LAS bf16x8*)(lds + L_QE + (16 * ti + fr) * RS128 + (64 * half + 32 * kk + 8 * fq) * 2);
#pragma unroll
                    for (int ei = 0; ei < 2; ++ei) O[ei][ti] = __builtin_amdgcn_mfma_f32_16x16x32_bf16(af[ei], bf, O[ei][ti], 0, 0, 0); }
            }
            asm volatile("s_waitcnt lgkmcnt(0)" ::: "memory");
        }
        __syncthreads();
        bf16x8 vf[2][2];
#pragma unroll
        for (int ei = 0; ei < 2; ++ei)
#pragma unroll
            for (int kk = 0; kk < 2; ++kk) vf[ei][kk] = tr_frag2(trb_v, 32 * kk * RSV + 32 * ei, 32 * kk * RSV + 32 * ei + 4 * RSV);
#pragma unroll
        for (int kk = 0; kk < 2; ++kk)
#pragma unroll
            for (int ti = 0; ti < 4; ++ti) { const bf16x8 bf = *(const LAS bf16x8*)(lds + L_ATT + (16 * ti + fr) * RS64 + (32 * kk + 8 * fq) * 2);
#pragma unroll
                for (int ei = 0; ei < 2; ++ei) O[ei][ti] = __builtin_amdgcn_mfma_f32_16x16x32_bf16(vf[ei][kk], bf, O[ei][ti], 0, 0, 0); }
        u32x2 rg[2][4];
        bf16_t* Rc = R + ((size_t)it.row0 + c * 64 + fr) * 1024 + head * 256 + 32 * w + 4 * fq; asm volatile("" : "+v"(Rc));
#pragma unroll
        for (int ei = 0; ei < 2; ++ei)
#pragma unroll
            for (int ti = 0; ti < 4; ++ti) { const int t = 16 * ti + fr; rg[ei][ti] = (u32x2){0u, 0u};
                if (t < L) rg[ei][ti] = *(const u32x2*)(Rc + ti * 16384 + 16 * ei); }
#pragma unroll
        for (int di = 0; di < 8; ++di) {
            const f32x4 eb = *(const LAS f32x4*)(lds + L_EBL + (16 * di + 4 * fq) * 4);
#pragma unroll
            for (int ei = 0; ei < 2; ++ei) S[di][ei] = S[di][ei] * eb;
#pragma unroll
            for (int kk = 0; kk < 2; ++kk) { const bf16x8 kf = tr_frag2(trb_k, 32 * kk * RS128 + 32 * di, 32 * kk * RS128 + 32 * di + 4 * RS128);
#pragma unroll
                for (int ei = 0; ei < 2; ++ei) S[di][ei] = __builtin_amdgcn_mfma_f32_16x16x32_bf16(kf, vf[ei][kk], S[di][ei], 0, 0, 0); }
        }
        { LAS f32x2* RED = (LAS f32x2*)(lds + L_RED);
#pragma unroll
          for (int ti = 0; ti < 4; ++ti) { float s1 = 0.f, s2 = 0.f;
#pragma unroll
              for (int ei = 0; ei < 2; ++ei)
#pragma unroll
                  for (int j = 0; j < 4; ++j) { const float x = O[ei][ti][j]; s1 += x; s2 += x * x; }
              s1 += __shfl_xor(s1, 16); s2 += __shfl_xor(s2, 16); s1 += __shfl_xor(s1, 32); s2 += __shfl_xor(s2, 32);
              if (fq == 0) RED[w * 64 + 16 * ti + fr] = (f32x2){s1, s2}; }
          __syncthreads();
#pragma unroll
          for (int ti = 0; ti < 4; ++ti) { const int t = 16 * ti + fr; float s1 = 0.f, s2 = 0.f;
#pragma unroll
              for (int ww = 0; ww < 8; ++ww) { const f32x2 p = RED[ww * 64 + t]; s1 += p.x; s2 += p.y; }
              const float mu = s1 * (1.0f / 256.0f), var = fmaxf(s2 * (1.0f / 256.0f) - mu * mu, 0.f), rstd = 1.0f / sqrtf(var + GN_EPS_);
              if (t < L) {
#pragma unroll
                  for (int ei = 0; ei < 2; ++ei) { const int e = 32 * w + 16 * ei + 4 * fq; const f32x4 g = *(const f32x4*)(gn + head * 256 + e); const f32x4 o = O[ei][ti];
                      const float r0 = bf_lo(rg[ei][ti].x), r1 = bf_hi(rg[ei][ti].x), r2 = bf_lo(rg[ei][ti].y), r3 = bf_hi(rg[ei][ti].y);
                      u32x2 pw; pw.x = cvt_pk_bf16(fast_silu(r0) * ((o[0] - mu) * rstd * g[0]), fast_silu(r1) * ((o[1] - mu) * rstd * g[1]));
                      pw.y = cvt_pk_bf16(fast_silu(r2) * ((o[2] - mu) * rstd * g[2]), fast_silu(r3) * ((o[3] - mu) * rstd * g[3]));
                      *(u32x2*)(Rc + ti * 16384 + 16 * ei) = pw; } }
          } }
    }
    {
        float* sp = it.Sout + (size_t)(4 * fq) * 256 + 32 * w + fr;
#pragma unroll
        for (int di = 0; di < 8; ++di) {
            float* pd = sp + di * 4096; asm volatile("" : "+v"(pd));
#pragma unroll
            for (int ei = 0; ei < 2; ++ei)
#pragma unroll
                for (int j = 0; j < 4; ++j) pd[j * 256 + 16 * ei] = S[di][ei][j];
        }
    }
    __syncthreads();
}

__device__ __forceinline__ void mixer_phase(LAS unsigned char* lds, int set, int l, bf16_t* Z, int M) {
    const int nitems = set == 0 ? 72 : 128;
    bf16_t* qg = Z; bf16_t* kg = Z + (size_t)M * 512; bf16_t* vg = Z + (size_t)M * 1024; bf16_t* rgp = Z + (size_t)M * 2048; bf16_t* lgp = Z + (size_t)M * 3072;
    bf16_t* qr = Z + (size_t)M * 3584; bf16_t* kr = Z + (size_t)M * 4096; bf16_t* vr = Z + (size_t)M * 4608; bf16_t* grp = Z + (size_t)M * 5632;
    const float* trig = (const float*)(CWS + WS_TRIG); float* smeta = (float*)(CWS + WS_SMETA);
    for (int itx = blockIdx.x; itx < nitems; itx += gridDim.x) {
        MixItem it; int ret;
        if (set == 0) {
            if (itx < 64) { ret = itx >> 5; const int bh = itx & 31, b = bh >> 2; it.head = bh & 3; it.row0 = b * 32; it.nch = 1; it.L = 32; it.pos0 = 1040;
                const size_t so = ((size_t)(l * 8 + b) * 4 + it.head) * 32768; it.Sin = CIN(ret ? 3 : 2) + so; it.Sout = COUT + (ret ? OUT_RET_S : OUT_GLA_S) + so; }
            else { const int j = itx - 64; ret = j >> 2; it.head = j & 3; it.row0 = 256; it.nch = 1; it.L = 16; it.pos0 = 0; it.Sin = nullptr; it.Sout = smeta + ((size_t)(l * 2 + ret) * 4 + it.head) * 32768; }
        } else {
            ret = itx >> 6; const int bh = itx & 63, b = bh >> 2; it.head = bh & 3; it.row0 = b * 2048; it.nch = 32; it.L = 64; it.pos0 = 16;
            it.Sin = smeta + ((size_t)(l * 2 + ret) * 4 + it.head) * 32768; it.Sout = COUT + (ret ? OUT_RET_P : OUT_GLA_P) + ((size_t)(l * 32 + (set - 1) * 16 + b) * 4 + it.head) * 32768;
        }
        if (ret) mixer_item<true>(lds, it, qr, kr, vr, nullptr, grp, nullptr, CIN(14) + (size_t)l * 1024, trig);
        else mixer_item<false>(lds, it, qg, kg, vg, lgp, rgp, CIN(11) + (size_t)l * 512, CIN(13) + (size_t)l * 1024, trig);
    }
}

#define SET_M   (set == 0 ? MSMALL : MBIG)
#define SET_H   (set == 0 ? COUT + OUT_YS : COUT + OUT_YP + (size_t)(set - 1) * MBIG * DM)
#define P_HB    ((bf16_t*)(CWS + WS_HB))
#define P_Z     ((bf16_t*)(CWS + WS_Z))
#define P_W     ((const bf16_t*)(CWS + WS_W) + (size_t)l * W_LAYER)
#define GEMM(EPI, A_, B_, N_, K_, ...) do { const int M = SET_M; pg8::Gemm g{A_, B_, M, N_, K_}; pg8::StaticOrder S; S.init(M, N_, (int)gridDim.x, (int)blockIdx.x); EPI E{__VA_ARGS__}; pg8::gemm_phase<EPI, pg8::StaticOrder>(lds, g, S, E, nullptr); } while (0)
__global__ void __launch_bounds__(512, 2) fwd_megakernel(Args a, int ph_lo, int ph_hi) {
    extern __shared__ __attribute__((aligned(16))) unsigned char shm[];
    LAS unsigned char* lds = (LAS unsigned char*)shm;
    cg::grid_group grid = cg::this_grid();
    if (threadIdx.x < 20) *(LAS unsigned long long*)(lds + CTX_OFF + 8 * threadIdx.x) = (unsigned long long)a.in[threadIdx.x];
    if (threadIdx.x == 20) *(LAS unsigned long long*)(lds + CTX_OFF + 8 * 20) = (unsigned long long)a.out;
    if (threadIdx.x == 21) *(LAS unsigned long long*)(lds + CTX_OFF + 8 * 21) = (unsigned long long)a.ws;
    if (threadIdx.x == 0) { *(LAS unsigned*)(lds + CTX_OFF + 192) = 0u; *(LAS unsigned*)(lds + CTX_OFF + 196) = 0u; }
    __syncthreads();
    const XcdBarrier bar = xcd_barrier_post((unsigned*)(a.ws + WS_CTL), (volatile LAS unsigned*)(lds + CTX_OFF + 192));
    int ph = 0;
#define PHASE(...) do { if (ph >= ph_lo && ph < ph_hi) { __VA_ARGS__; if (ph + 1 < ph_hi) { if (ph == 0) grid.sync(); else xcd_barrier(bar); } } ++ph; } while (0)
    PHASE(prologue(lds));
    for (int set = 0; set < 3; ++set) {
        PHASE(init_set(lds, set, SET_H, P_HB));
        for (int l = 0; l < DEPTH_; ++l) {
            PHASE(GEMM(pg8::EpiSwiglu, P_HB, P_W + W_UP1, 2 * DFF, DM, P_Z, DFF));
            PHASE(GEMM(pg8::EpiResid, P_Z, P_W + W_DN1, DM, DFF, SET_H, DN_ALPHA_, 0.5f));
            PHASE(ln_phase(SET_H, P_HB, SET_M, CIN(5) + (size_t)l * 3 * DM, CIN(6) + (size_t)l * 3 * DM));
            PHASE(GEMM(pg8::EpiZ, P_HB, P_W + W_IN, NZ, DM, P_Z, M));
            PHASE(mixer_phase(lds, set, l, P_Z, SET_M));
            PHASE(GEMM(pg8::EpiGate<false>, P_Z + (size_t)M * 2048, P_W + W_OA, DM, DM, P_Z + (size_t)M * 6656, CIN(12) + (size_t)l * 2048, 0, nullptr, P_Z + (size_t)M * 1024));
            PHASE(GEMM(pg8::EpiGate<true>, P_Z + (size_t)M * 5632, P_W + W_OB, DM, DM, P_Z + (size_t)M * 6656, CIN(12) + (size_t)l * 2048, 1024, P_Z + (size_t)M * 1024, P_Z + (size_t)M * 4608));
            PHASE(GEMM(pg8::EpiResid, P_Z + (size_t)M * 4608, P_W + W_O, DM, DM, SET_H, DN_ALPHA_, 1.0f));
            PHASE(ln_phase(SET_H, P_HB, SET_M, CIN(5) + (size_t)(l * 3 + 1) * DM, CIN(6) + (size_t)(l * 3 + 1) * DM));
            PHASE(GEMM(pg8::EpiSwiglu, P_HB, P_W + W_UP2, 2 * DFF, DM, P_Z, DFF));
            PHASE(GEMM(pg8::EpiResid, P_Z, P_W + W_DN2, DM, DFF, SET_H, DN_ALPHA_, 0.5f));
            PHASE(ln_phase(SET_H, P_HB, SET_M, CIN(5) + (size_t)(l * 3 + 2) * DM, CIN(6) + (size_t)(l * 3 + 2) * DM));
        }
    }
#undef PHASE
}
constexpr int N_PHASES = 1 + 3 * (1 + 4 * 12);

extern "C" void kernel_launch(void* const* d_in, const int* in_sizes, int n_in, void* d_out, int out_size, void* d_ws, size_t ws_size, hipStream_t stream) {
    static int grid = 0;
    if (grid == 0) {
        int dev = 0, cus = 0, per_cu = 0;
        hipGetDevice(&dev); hipDeviceGetAttribute(&cus, hipDeviceAttributeMultiprocessorCount, dev);
        hipFuncSetAttribute((const void*)fwd_megakernel, hipFuncAttributeMaxDynamicSharedMemorySize, LDS_BYTES);
        hipOccupancyMaxActiveBlocksPerMultiprocessor(&per_cu, (const void*)fwd_megakernel, 512, LDS_BYTES);
        if (per_cu < 1) per_cu = 1;
        grid = cus * (per_cu > 1 ? 1 : per_cu);
        if (ws_size < WS_END) { fprintf(stderr, "kernel_launch: workspace too small: %zu < %zu\n", ws_size, (size_t)WS_END); }
        (void)hipGetLastError();
    }
    (void)hipMemsetAsync((char*)d_ws + WS_CTL, 0, 16384, stream);
    Args a{};
    for (int i = 0; i < 20; ++i) a.in[i] = (const float*)d_in[i];
    a.out = (float*)d_out; a.ws = (unsigned char*)d_ws;
    int lo = 0, hi = N_PHASES;
    void* args[] = {&a, &lo, &hi};
    hipError_t e = hipLaunchCooperativeKernel((const void*)fwd_megakernel, dim3(grid), dim3(512), args, LDS_BYTES, stream);
    if (e != hipSuccess) fprintf(stderr, "cooperative launch failed: %s (grid %d)\n", hipGetErrorString(e), grid);
}
```

```cpp
#include <hip/hip_runtime.h>
#include <hip/hip_cooperative_groups.h>
#include <cstdio>
namespace cg = cooperative_groups;

#define LAS __attribute__((address_space(3)))
typedef unsigned short bf16_t;
typedef short bf16x8 __attribute__((ext_vector_type(8)));
typedef short s16x4 __attribute__((ext_vector_type(4)));
typedef float f32x4 __attribute__((ext_vector_type(4)));
typedef float f32x2 __attribute__((ext_vector_type(2)));
typedef unsigned u32x4 __attribute__((ext_vector_type(4)));
typedef unsigned u32x2 __attribute__((ext_vector_type(2)));

constexpr int DM = 1024, DFF = 2816, NZ = 8704, DEPTH_ = 4;
constexpr int MBIG = 32768, MSMALL = 512, NPOS = 2064;
constexpr float DN_ALPHA_ = 1.681792830507429f;
constexpr float LN_EPS_ = 1e-5f, GN_EPS_ = 1e-5f;
constexpr size_t OUT_YP = 0, OUT_YS = 67108864, OUT_GLA_P = 67371008, OUT_RET_P = 84148224, OUT_GLA_S = 100925440, OUT_RET_S = 105119744;
constexpr size_t W_UP1 = 0, W_DN1 = 5767168, W_IN = 8650752, W_OA = 17563648, W_OB = 18612224, W_O = 19660800, W_UP2 = 20709376, W_DN2 = 26476544, W_LAYER = 29360128;
constexpr size_t WS_CTL = 0, WS_TRIG = 65536, WS_SMETA = WS_TRIG + 2097152, WS_W = WS_SMETA + 4194304, WS_HB = WS_W + W_LAYER * 2 * 4,
                 WS_Z = WS_HB + (size_t)MBIG * DM * 2, WS_END = WS_Z + (size_t)MBIG * NZ * 2;
constexpr int LDS_BYTES = 148736;

__device__ __forceinline__ unsigned cvt_pk_bf16(float lo, float hi) { unsigned r; asm volatile("v_cvt_pk_bf16_f32 %0, %1, %2" : "=v"(r) : "v"(lo), "v"(hi)); return r; }
__device__ __forceinline__ float bf_lo(unsigned w) { return __uint_as_float(w << 16); }
__device__ __forceinline__ float bf_hi(unsigned w) { return __uint_as_float(w & 0xffff0000u); }
__device__ __forceinline__ float fast_sigmoid(float x) { return __builtin_amdgcn_rcpf(1.0f + __expf(-x)); }
__device__ __forceinline__ float fast_silu(float x) { return x * fast_sigmoid(x); }

namespace pg8 {
#define PG8_LAS __attribute__((address_space(3)))
typedef unsigned short bf16_t;
typedef short bf16x8 __attribute__((ext_vector_type(8)));
typedef float f32x4 __attribute__((ext_vector_type(4)));
typedef unsigned u32x4 __attribute__((ext_vector_type(4)));
constexpr int BM = 256, BK = 64, HALF = 128, HTB = HALF * BK * 2  , STAGE_BYTES = 8 * HTB, NXCD = 8, WGM = 8;

__host__ __device__ __forceinline__ int lds_byte(int r, int c) { const int st = (r >> 4) * 2 + (c >> 5), rr = r & 15, cc = c & 31, ob = rr * 64 + cc * 2; return st * 1024 + (ob ^ (((ob >> 9) & 1) << 5)); }
__host__ __device__ __forceinline__ void stage_rc(int b, int& R, int& C) { const int st = b / 1024, sb = b % 1024, swz = sb ^ (((sb >> 9) & 1) << 5); R = (st >> 1) * 16 + swz / 64; C = (st & 1) * 32 + (swz % 64) / 2; }
__host__ __device__ __forceinline__ int perm32(int rho) { const int n = rho >> 4, i = rho & 15; return 8 * (i >> 2) + 4 * n + (i & 3); }

struct Unit { int pm, pn; };
struct Gemm { const bf16_t* A; const bf16_t* Bt; int M, N, K; };

struct StaticOrder {
    int nM, nN, nwg, G, c;
    __host__ __device__ void init(int M, int N, int G_, int c_) { nM = M / BM; nN = N / BM; nwg = nM * nN; G = G_; c = c_; }
    __host__ __device__ bool next(int i, Unit& u) const {
        const long L = (long)i * G + c; if (L >= nwg) return false;
        int wgid = (int)L; { const int q = nwg / NXCD, r = nwg % NXCD, xcd = wgid % NXCD, off = wgid / NXCD; wgid = (xcd < r ? xcd * (q + 1) : r * (q + 1) + (xcd - r) * q) + off; }
        const int nig = WGM * nN, gid = wgid / nig, fm = gid * WGM, gsz = (nM - fm) < WGM ? (nM - fm) : WGM;
        u.pm = fm + ((wgid % nig) % gsz); u.pn = (wgid % nig) / gsz; return true;
    }
    __device__ __forceinline__ void a_ready(const Unit&) const {}
    __device__ __forceinline__ void done(const Unit&) const {}
};


struct EpiSwiglu {
    static constexpr bool PERM = true, AFTER_DRAIN = false;
    bf16_t* U; int ldc;
    __device__ __forceinline__ void operator()(const f32x4 (&acc)[2][2][4][2], const Unit& u, int wr, int wc, int fr, int fq) const {
        const int row0 = u.pm * BM + wr * 64 + fr, col0 = u.pn * 128 + wc * 32 + 8 * fq;
#pragma unroll
        for (int ai = 0; ai < 2; ++ai)
#pragma unroll
            for (int m = 0; m < 4; ++m) {
                bf16_t* rowp = U + (size_t)(row0 + ai * HALF + m * 16) * ldc + col0;
                const f32x4 a0 = acc[ai][0][m][0], a1 = acc[ai][0][m][1], b0 = acc[ai][1][m][0], b1 = acc[ai][1][m][1];
                u32x4 w;
                w.x = cvt_pk_bf16(fast_silu(a0[0]) * b0[0], fast_silu(a0[1]) * b0[1]); w.y = cvt_pk_bf16(fast_silu(a0[2]) * b0[2], fast_silu(a0[3]) * b0[3]);
                w.z = cvt_pk_bf16(fast_silu(a1[0]) * b1[0], fast_silu(a1[1]) * b1[1]); w.w = cvt_pk_bf16(fast_silu(a1[2]) * b1[2], fast_silu(a1[3]) * b1[3]);
                *(u32x4*)rowp = w;
            }
    }
};
struct EpiResid {
    static constexpr bool PERM = false, AFTER_DRAIN = false;
    float* H; float alpha, s;
    __device__ __forceinline__ void operator()(const f32x4 (&acc)[2][2][4][2], const Unit& u, int wr, int wc, int fr, int fq) const {
        const int row0 = u.pm * BM + wr * 64 + fr, col0 = u.pn * BM + wc * 32 + 4 * fq;
#pragma unroll
        for (int ai = 0; ai < 2; ++ai)
#pragma unroll
            for (int m = 0; m < 4; ++m) { float* rowp = H + (size_t)(row0 + ai * HALF + m * 16) * DM + col0;
#pragma unroll
                for (int bj = 0; bj < 2; ++bj)
#pragma unroll
                    for (int n = 0; n < 2; ++n) { float* p = rowp + bj * HALF + n * 16; const f32x4 h = *(const f32x4*)p; *(f32x4*)p = h * alpha + acc[ai][bj][m][n] * s; } }
    }
};
struct EpiZ {
    static constexpr bool PERM = true, AFTER_DRAIN = false;
    bf16_t* Z; int M;
    __device__ __forceinline__ void operator()(const f32x4 (&acc)[2][2][4][2], const Unit& u, int wr, int wc, int fr, int fq) const {
        const int pn = u.pn; int ts, cs, wd;
        if (pn < 2) { ts = 0; cs = 0; wd = 512; } else if (pn < 4) { ts = 2; cs = 512; wd = 512; } else if (pn < 8) { ts = 4; cs = 1024; wd = 1024; } else if (pn < 12) { ts = 8; cs = 2048; wd = 1024; }
        else if (pn < 14) { ts = 12; cs = 3072; wd = 512; } else if (pn < 16) { ts = 14; cs = 3584; wd = 512; } else if (pn < 18) { ts = 16; cs = 4096; wd = 512; } else if (pn < 22) { ts = 18; cs = 4608; wd = 1024; }
        else if (pn < 26) { ts = 22; cs = 5632; wd = 1024; } else { ts = 26; cs = 6656; wd = 2048; }
        bf16_t* base = Z + (size_t)M * cs;
        const int row0 = u.pm * BM + wr * 64 + fr, col0 = (pn - ts) * BM + wc * 32 + 8 * fq;
#pragma unroll
        for (int ai = 0; ai < 2; ++ai)
#pragma unroll
            for (int m = 0; m < 4; ++m) { bf16_t* rowp = base + (size_t)(row0 + ai * HALF + m * 16) * wd + col0;
#pragma unroll
                for (int bj = 0; bj < 2; ++bj) { const f32x4 v0 = acc[ai][bj][m][0], v1 = acc[ai][bj][m][1];
                    u32x4 w; w.x = cvt_pk_bf16(v0[0], v0[1]); w.y = cvt_pk_bf16(v0[2], v0[3]); w.z = cvt_pk_bf16(v1[0], v1[1]); w.w = cvt_pk_bf16(v1[2], v1[3]);
                    *(u32x4*)(rowp + bj * HALF) = w; } }
    }
};
template <bool ADD> struct EpiGate {
    static constexpr bool PERM = true, AFTER_DRAIN = false;
    const bf16_t* MG; const float* bm; int goff; const bf16_t* prev; bf16_t* out;
    __device__ __forceinline__ void operator()(const f32x4 (&acc)[2][2][4][2], const Unit& u, int wr, int wc, int fr, int fq) const {
        const int row0 = u.pm * BM + wr * 64 + fr, col0 = u.pn * BM + wc * 32 + 8 * fq;
#pragma unroll
        for (int ai = 0; ai < 2; ++ai)
#pragma unroll
            for (int m = 0; m < 4; ++m) { const size_t row = (size_t)(row0 + ai * HALF + m * 16);
#pragma unroll
                for (int bj = 0; bj < 2; ++bj) { const int c = col0 + bj * HALF;
                    const u32x4 g = *(const u32x4*)(MG + row * 2048 + goff + c);
                    const f32x4 bA = *(const f32x4*)(bm + goff + c), bB = *(const f32x4*)(bm + goff + c + 4);
                    const f32x4 v0 = acc[ai][bj][m][0], v1 = acc[ai][bj][m][1];
                    float r[8];
                    r[0] = fast_sigmoid(bf_lo(g.x) + bA[0]) * v0[0]; r[1] = fast_sigmoid(bf_hi(g.x) + bA[1]) * v0[1];
                    r[2] = fast_sigmoid(bf_lo(g.y) + bA[2]) * v0[2]; r[3] = fast_sigmoid(bf_hi(g.y) + bA[3]) * v0[3];
                    r[4] = fast_sigmoid(bf_lo(g.z) + bB[0]) * v1[0]; r[5] = fast_sigmoid(bf_hi(g.z) + bB[1]) * v1[1];
                    r[6] = fast_sigmoid(bf_lo(g.w) + bB[2]) * v1[2]; r[7] = fast_sigmoid(bf_hi(g.w) + bB[3]) * v1[3];
                    if (ADD) { const u32x4 p = *(const u32x4*)(prev + row * DM + c);
                        r[0] += bf_lo(p.x); r[1] += bf_hi(p.x); r[2] += bf_lo(p.y); r[3] += bf_hi(p.y); r[4] += bf_lo(p.z); r[5] += bf_hi(p.z); r[6] += bf_lo(p.w); r[7] += bf_hi(p.w); }
                    u32x4 w; w.x = cvt_pk_bf16(r[0], r[1]); w.y = cvt_pk_bf16(r[2], r[3]); w.z = cvt_pk_bf16(r[4], r[5]); w.w = cvt_pk_bf16(r[6], r[7]);
                    *(u32x4*)(out + row * DM + c) = w; } }
    }
};

template <class Epi, class Sched, bool STAMP = false>
__device__ __forceinline__ void gemm_phase(PG8_LAS unsigned char* lds, const Gemm g, const Sched& S, const Epi& E, unsigned long long* stamps) {
    int tid = threadIdx.x; asm volatile("" : "+v"(tid)); const int wid = __builtin_amdgcn_readfirstlane(tid >> 6), lane = tid & 63, wr = wid >> 2, wc = wid & 3, fr = lane & 15, fq = lane >> 4;
    const int K = g.K, nt = K / BK;
    int ts_lo = 0, ts_hi = 0, nts = 0; const unsigned long long rt_entry = STAMP ? (unsigned long long)wall_clock64() : 0ull;
#define PG8_STAMP() do { if (STAMP && wid == 0 && nts < 64) { const unsigned long long _c = (unsigned long long)clock64(); \
        ts_lo = (lane == nts) ? (int)(unsigned)_c : ts_lo; ts_hi = (lane == nts) ? (int)(unsigned)(_c >> 32) : ts_hi; ++nts; } } while (0)
    PG8_STAMP();
    unsigned voffA[2], voffB[2];
#pragma unroll
    for (int i = 0; i < 2; ++i) { int R, C; stage_rc(tid * 16 + i * 8192, R, C); const int Rb = Epi::PERM ? ((R & ~31) + perm32(R & 31)) : R;
        voffA[i] = (unsigned)(R * K + C) * 2u; voffB[i] = (unsigned)(Rb * K + C) * 2u; }
    const size_t kstep = (size_t)(BK * 2);
    const size_t hstep = (size_t)HALF * K * 2;
    const size_t tstep = 2 * hstep;
    const unsigned ldsw = (unsigned)wid * 1024u;
    const int aoff = lds_byte(wr * 64 + fr, fq * 8), boff = lds_byte(wc * 32 + fr, fq * 8);
#define PG8_SA(b, h) (((b) * 2 + (h)) * HTB)
#define PG8_SB(b, h) ((4 + (b) * 2 + (h)) * HTB)
#define PG8_STAGE(bufoff, gbase, voff) do { _Pragma("unroll") for (int _i = 0; _i < 2; ++_i) \
        __builtin_amdgcn_global_load_lds((const unsigned*)((const char*)(gbase) + (voff)[_i]), (PG8_LAS unsigned*)(lds + (bufoff) + ldsw + _i * 8192), 16, 0, 0); } while (0)
#define PG8_LDA(dst, b, h) do { _Pragma("unroll") for (int m = 0; m < 4; ++m) _Pragma("unroll") for (int k = 0; k < 2; ++k) dst[m][k] = *(const PG8_LAS bf16x8*)(lds + PG8_SA(b, h) + aoff + m * 2048 + k * 1024); } while (0)
#define PG8_LDB(dst, b, h) do { _Pragma("unroll") for (int n = 0; n < 2; ++n) _Pragma("unroll") for (int k = 0; k < 2; ++k) dst[n][k] = *(const PG8_LAS bf16x8*)(lds + PG8_SB(b, h) + boff + n * 2048 + k * 1024); } while (0)
#define PG8_MMA(ai, bj, At, Bt) do { __builtin_amdgcn_s_setprio(1); _Pragma("unroll") for (int m = 0; m < 4; ++m) _Pragma("unroll") for (int n = 0; n < 2; ++n) _Pragma("unroll") for (int k = 0; k < 2; ++k) \
        acc[ai][bj][m][n] = __builtin_amdgcn_mfma_f32_16x16x32_bf16(Bt[n][k], At[m][k], acc[ai][bj][m][n], 0, 0, 0); __builtin_amdgcn_s_setprio(0); } while (0)
#define PG8_WAIT_V(n) asm volatile("s_waitcnt vmcnt(" #n ")" ::: "memory")
#define PG8_WAIT_L(n) asm volatile("s_waitcnt lgkmcnt(" #n ")" ::: "memory")
#define PG8_BAR __builtin_amdgcn_s_barrier()
#define PG8_SCHED __builtin_amdgcn_sched_barrier(0)
    Unit cur, nxt; int ui = 0;
    if (!S.next(0, cur)) return;
    f32x4 acc[2][2][4][2];
#pragma unroll
    for (int a = 0; a < 2; ++a)
#pragma unroll
        for (int b = 0; b < 2; ++b)
#pragma unroll
            for (int m = 0; m < 4; ++m)
#pragma unroll
                for (int n = 0; n < 2; ++n) acc[a][b][m][n] = (f32x4){0.f, 0.f, 0.f, 0.f};
    bf16x8 At[4][2], B0[2][2], B1[2][2];
    const char* cA = (const char*)g.A + (size_t)cur.pm * tstep; const char* cB = (const char*)g.Bt + (size_t)cur.pn * tstep;
    S.a_ready(cur);
    PG8_STAGE(PG8_SB(0, 0), cB, voffB); PG8_STAGE(PG8_SA(0, 0), cA, voffA); PG8_STAGE(PG8_SB(0, 1), cB + hstep, voffB); PG8_STAGE(PG8_SA(0, 1), cA + hstep, voffA);
    if (wr == 1) PG8_BAR;
    PG8_WAIT_V(4); PG8_BAR;
    PG8_STAGE(PG8_SB(1, 0), cB + kstep, voffB); PG8_STAGE(PG8_SA(1, 0), cA + kstep, voffA); PG8_STAGE(PG8_SB(1, 1), cB + hstep + kstep, voffB);
    PG8_WAIT_V(6); PG8_BAR;
    PG8_STAMP();
    for (;;) {
        const bool has_next = S.next(ui + 1, nxt);
        const char* nA = has_next ? (const char*)g.A + (size_t)nxt.pm * tstep : cA; const char* nB = has_next ? (const char*)g.Bt + (size_t)nxt.pn * tstep : cB;
        for (int t = 0; t < nt; t += 2) {
            const bool last = (t == nt - 2);
            const char* a1 = cA + (size_t)(t + 1) * kstep;
            const char* a2 = last ? nA : cA + (size_t)(t + 2) * kstep; const char* b2 = last ? nB : cB + (size_t)(t + 2) * kstep;
            const char* a3 = a2 + kstep; const char* b3 = b2 + kstep;
            if (last && has_next) S.a_ready(nxt);
            PG8_LDB(B0, 0, 0); PG8_SCHED; PG8_LDA(At, 0, 0); PG8_STAGE(PG8_SA(1, 1), a1 + hstep, voffA);
            PG8_WAIT_L(8); PG8_BAR; PG8_WAIT_L(0); PG8_MMA(0, 0, At, B0); PG8_BAR; PG8_SCHED;
            PG8_LDB(B1, 0, 1); PG8_STAGE(PG8_SB(0, 0), b2, voffB);
            PG8_BAR; PG8_WAIT_L(0); PG8_MMA(0, 1, At, B1); PG8_BAR;
            PG8_LDA(At, 0, 1); PG8_STAGE(PG8_SA(0, 0), a2, voffA);
            PG8_BAR; PG8_WAIT_L(0); PG8_MMA(1, 0, At, B0); PG8_BAR; PG8_SCHED;
            PG8_STAGE(PG8_SB(0, 1), b2 + hstep, voffB);
            PG8_WAIT_V(6); PG8_BAR; PG8_MMA(1, 1, At, B1); PG8_BAR;
            PG8_LDB(B0, 1, 0); PG8_SCHED; PG8_LDA(At, 1, 0); PG8_STAGE(PG8_SA(0, 1), a2 + hstep, voffA);
            PG8_WAIT_L(8); PG8_BAR; PG8_WAIT_L(0); PG8_MMA(0, 0, At, B0); PG8_BAR; PG8_SCHED;
            PG8_LDB(B1, 1, 1); PG8_STAGE(PG8_SB(1, 0), b3, voffB);
            PG8_BAR; PG8_WAIT_L(0); PG8_MMA(0, 1, At, B1); PG8_BAR;
            PG8_LDA(At, 1, 1); PG8_STAGE(PG8_SA(1, 0), a3, voffA);
            PG8_BAR; PG8_WAIT_L(0); PG8_MMA(1, 0, At, B0); PG8_BAR; PG8_SCHED;
            PG8_STAGE(PG8_SB(1, 1), b3 + hstep, voffB);
            PG8_WAIT_V(6); PG8_BAR; PG8_MMA(1, 1, At, B1); PG8_BAR;
        }
        PG8_STAMP();
        if constexpr (!Epi::AFTER_DRAIN) { E(acc, cur, wr, wc, fr, fq); S.done(cur); }
        PG8_STAMP();
        if (!has_next) break;
#pragma unroll
        for (int a = 0; a < 2; ++a)
#pragma unroll
            for (int b = 0; b < 2; ++b)
#pragma unroll
                for (int m = 0; m < 4; ++m)
#pragma unroll
                    for (int n = 0; n < 2; ++n) acc[a][b][m][n] = (f32x4){0.f, 0.f, 0.f, 0.f};
        cur = nxt; cA = nA; cB = nB; ++ui;
    }
    PG8_WAIT_V(0);
    if (wr == 0) PG8_BAR;
    PG8_BAR;
    if constexpr (Epi::AFTER_DRAIN) { E.fused(acc, cur, wr, wc, fr, fq, lds, wid, lane); S.done(cur); }
    PG8_STAMP();
    if (STAMP && wid == 0) { stamps[lane] = lane < nts ? (((unsigned long long)(unsigned)ts_hi << 32) | (unsigned)ts_lo) : 0ull;
        if (lane == 62) stamps[62] = rt_entry; if (lane == 63) stamps[63] = (unsigned long long)wall_clock64(); }
#undef PG8_STAMP
#undef PG8_SA
#undef PG8_SB
#undef PG8_STAGE
#undef PG8_LDA
#undef PG8_LDB
#undef PG8_MMA
#undef PG8_WAIT_V
#undef PG8_WAIT_L
#undef PG8_BAR
#undef PG8_SCHED
}
}
#define XB_TMO      128
#define XB_XCNT(j)  (256  + 64 * (j))
#define XB_XSUB(j)  (1280 + 64 * (j))
#define XB_XGEN(j)  (2304 + 64 * (j))
#define XB_TOP      3328
#define XB_TOPGEN   3392
#define XCD_BAR_WORDS 3456
#define XB_SPIN_CAP (1u << 18)

__device__ __forceinline__ unsigned xb_ld(unsigned* p)              { return __hip_atomic_load(p, __ATOMIC_RELAXED, __HIP_MEMORY_SCOPE_AGENT); }
__device__ __forceinline__ unsigned xb_add(unsigned* p, unsigned v) { return __hip_atomic_fetch_add(p, v, __ATOMIC_RELAXED, __HIP_MEMORY_SCOPE_AGENT); }
__device__ __forceinline__ unsigned xb_xcc_id() { return (unsigned)__builtin_amdgcn_s_getreg((3 << 11) | 20) & 0xFu; }
#define XB_SPIN(cond, bar) do { unsigned _sp = 0; while (cond) { __builtin_amdgcn_s_sleep(1); \
    if ((++_sp & 255u) == 0u) { if (xb_ld(&(bar)[XB_TMO])) break; if (_sp > XB_SPIN_CAP) { atomicAdd(&(bar)[XB_TMO], 1u); break; } } } } while (0)

struct XcdBarrier {
    unsigned* bar; unsigned x;
    volatile LAS unsigned* st;
};

__device__ __forceinline__ XcdBarrier xcd_barrier_post(unsigned* bar, volatile LAS unsigned* st) {
    XcdBarrier b; b.bar = bar; b.x = xb_xcc_id(); b.st = st;
    if (threadIdx.x == 0) (void)xb_add(&bar[XB_XCNT(b.x)], 1u);
    return b;
}
__device__ __forceinline__ void xcd_barrier_complete(unsigned* bar, unsigned x, unsigned& nloc, unsigned& nx) {
    const unsigned G = gridDim.x * gridDim.y * gridDim.z;
    unsigned sum, cnt, mine, sp = 0u;
    for (;;) {
        sum = 0u; cnt = 0u; mine = 0u;
#pragma unroll
        for (unsigned j = 0; j < 16; ++j) { const unsigned c = xb_ld(&bar[XB_XCNT(j)]); sum += c; cnt += (c > 0u) ? 1u : 0u; mine = (j == x) ? c : mine; }
        if (sum == G) break;
        __builtin_amdgcn_s_sleep(1);
        if ((++sp & 255u) == 0u) { if (xb_ld(&bar[XB_TMO])) break; if (sp > XB_SPIN_CAP) { atomicAdd(&bar[XB_TMO], 1u); break; } }
    }
    nloc = mine > 0u ? mine : 1u; nx = cnt > 0u ? cnt : 1u;
}

__device__ __forceinline__ void xcd_barrier(const XcdBarrier& b) {
    asm volatile("s_waitcnt vmcnt(0)" ::: "memory");
    __syncthreads();
    if (threadIdx.x == 0) {
        unsigned* bar = b.bar;
        __builtin_amdgcn_s_waitcnt(0);
        unsigned nloc = b.st[0], nx = b.st[1];
        if (nloc == 0u) { xcd_barrier_complete(bar, b.x, nloc, nx); b.st[0] = nloc; b.st[1] = nx; }
        const unsigned old = xb_add(&bar[XB_XSUB(b.x)], 1u);
        const unsigned gen = old / nloc;
        if (old + 1u == (gen + 1u) * nloc) {
            __builtin_amdgcn_fence(__ATOMIC_RELEASE, "agent");
            asm volatile("s_waitcnt vmcnt(0)" ::: "memory");
            const unsigned og = xb_add(&bar[XB_TOP], 1u);
            const unsigned tg = og / nx;
            if (og + 1u == (tg + 1u) * nx) xb_add(&bar[XB_TOPGEN], 1u);
            else XB_SPIN(xb_ld(&bar[XB_TOPGEN]) == tg, bar);
            __builtin_amdgcn_fence(__ATOMIC_ACQUIRE, "agent");
            xb_add(&bar[XB_XGEN(b.x)], 1u);
            asm volatile("s_waitcnt vmcnt(0)" ::: "memory");
        } else {
            XB_SPIN(xb_ld(&bar[XB_XGEN(b.x)]) == gen, bar);
            __builtin_amdgcn_fence(__ATOMIC_ACQUIRE, "agent");
            asm volatile("s_waitcnt vmcnt(0)" ::: "memory");
        }
    }
    __syncthreads();
}

#define GAS __attribute__((address_space(1)))

__device__ __forceinline__ int map_up(int R) { return ((R >> 7) & 1) * DFF + (R >> 8) * 128 + (R & 127); }
__device__ __forceinline__ int map_in(int R) { return R < 3072 ? R : R - 496; }
__device__ __forceinline__ void transpose_tile(LAS unsigned char* lds, const float* src, int ldsrc, bf16_t* dst, int K, int R0, int k0, int kind, const float* wa2) {
    int tid = threadIdx.x; asm volatile("" : "+v"(tid));
    const int r = tid & 63, kq = tid >> 6;
    LAS bf16_t* T = (LAS bf16_t*)lds;
    const int R = R0 + r;
    if (kind == 3) {
        const int j = R - 3072; float wa[16];
#pragma unroll
        for (int q = 0; q < 16; ++q) wa[q] = wa2[q * 512 + j];
#pragma unroll 4
        for (int i = 0; i < 16; ++i) { const int kk = i * 8 + kq; const float* p = src + (size_t)(k0 + kk) * ldsrc + 3072; float s = 0.f;
#pragma unroll
            for (int q = 0; q < 16; ++q) s += p[q] * wa[q];
            T[r * 136 + kk] = (bf16_t)(cvt_pk_bf16(s, 0.f) & 0xffffu); }
    } else {
        const int col = kind == 1 ? map_up(R) : (kind == 2 ? map_in(R) : R);
#pragma unroll 4
        for (int i = 0; i < 16; ++i) { const int kk = i * 8 + kq; const float v = src[(size_t)(k0 + kk) * ldsrc + col]; T[r * 136 + kk] = (bf16_t)(cvt_pk_bf16(v, 0.f) & 0xffffu); }
    }
    __syncthreads();
#pragma unroll
    for (int h = 0; h < 2; ++h) { const int id = tid + h * 512, rr = id >> 4, sg = id & 15;
        const u32x4 v = *(const LAS u32x4*)(lds + rr * 272 + sg * 16);
        *(u32x4*)(dst + (size_t)(R0 + rr) * K + k0 + sg * 8) = v; }
    __syncthreads();
}

struct Args { const float* in[20]; float* out; unsigned char* ws; };
constexpr int CTX_OFF = 148480;
__device__ __forceinline__ unsigned long long ctx_ld(LAS unsigned char* lds, int i) {
    const unsigned long long v = *(volatile LAS unsigned long long*)(lds + CTX_OFF + 8 * i);
    const unsigned lo = __builtin_amdgcn_readfirstlane((unsigned)v), hi = __builtin_amdgcn_readfirstlane((unsigned)(v >> 32));
    return ((unsigned long long)hi << 32) | lo;
}
#define CIN(i) ((const float*)(const GAS float*)ctx_ld(lds, (i)))
#define COUT   ((float*)(GAS float*)ctx_ld(lds, 20))
#define CWS    ((unsigned char*)(GAS unsigned char*)ctx_ld(lds, 21))

__device__ __forceinline__ void prologue(LAS unsigned char* lds) {
    for (int tile = blockIdx.x; tile < 3584 * 4; tile += gridDim.x) {
        const int l = tile / 3584; int r = tile % 3584;
        bf16_t* W = (bf16_t*)(CWS + WS_W) + (size_t)l * W_LAYER;
        if (r < 704) { transpose_tile(lds, CIN(7) + (size_t)l * DM * 2 * DFF, 2 * DFF, W + W_UP1, DM, (r >> 3) * 64, (r & 7) * 128, 1, nullptr); continue; } r -= 704;
        if (r < 352) { transpose_tile(lds, CIN(8) + (size_t)l * DFF * DM, DM, W + W_DN1, DFF, (r / 22) * 64, (r % 22) * 128, 0, nullptr); continue; } r -= 352;
        if (r < 1088) { const int R0 = (r >> 3) * 64; transpose_tile(lds, CIN(9) + (size_t)l * DM * 8208, 8208, W + W_IN, DM, R0, (r & 7) * 128, (R0 >= 3072 && R0 < 3584) ? 3 : 2, CIN(10) + (size_t)l * 16 * 512); continue; } r -= 1088;
        if (r < 128) { transpose_tile(lds, CIN(15) + (size_t)l * DM * DM, DM, W + W_OA, DM, (r >> 3) * 64, (r & 7) * 128, 0, nullptr); continue; } r -= 128;
        if (r < 128) { transpose_tile(lds, CIN(16) + (size_t)l * DM * DM, DM, W + W_OB, DM, (r >> 3) * 64, (r & 7) * 128, 0, nullptr); continue; } r -= 128;
        if (r < 128) { transpose_tile(lds, CIN(17) + (size_t)l * DM * DM, DM, W + W_O, DM, (r >> 3) * 64, (r & 7) * 128, 0, nullptr); continue; } r -= 128;
        if (r < 704) { transpose_tile(lds, CIN(18) + (size_t)l * DM * 2 * DFF, 2 * DFF, W + W_UP2, DM, (r >> 3) * 64, (r & 7) * 128, 1, nullptr); continue; } r -= 704;
        transpose_tile(lds, CIN(19) + (size_t)l * DFF * DM, DM, W + W_DN2, DFF, (r / 22) * 64, (r % 22) * 128, 0, nullptr);
    }
    float* trig = (float*)(CWS + WS_TRIG);
    for (int idx = blockIdx.x * 512 + threadIdx.x; idx < NPOS * 64; idx += gridDim.x * 512) {
        const int pos = idx >> 6, i = idx & 63;
        double inv = 1.0; for (int q = 0; q < i; ++q) inv *= 0.8659643233600653;
        const double rev = (double)pos * inv * 0.15915494309189535; const float fr = (float)(rev - __builtin_rint(rev));
        trig[idx] = __builtin_amdgcn_cosf(fr); trig[NPOS * 64 + idx] = __builtin_amdgcn_sinf(fr);
    }
}

__device__ __forceinline__ void init_set(LAS unsigned char* lds, int set, float* h32, bf16_t* hb) {
    const int M = set == 0 ? MSMALL : MBIG;
    const size_t n4 = (size_t)M * DM / 4;
    for (size_t i = (size_t)blockIdx.x * 512 + threadIdx.x; i < n4; i += (size_t)gridDim.x * 512) {
        const size_t row = i >> 8; const int c4 = (int)(i & 255);
        f32x4 v = (f32x4){0.f, 0.f, 0.f, 0.f};
        if (set == 0) { if (row < 256) v = *(const f32x4*)(CIN(1) + row * DM + c4 * 4); else if (row < 272) v = *(const f32x4*)(CIN(4) + (row - 256) * DM + c4 * 4); }
        else v = *(const f32x4*)(CIN(0) + ((size_t)(set - 1) * MBIG + row) * DM + c4 * 4);
        *(f32x4*)(h32 + i * 4) = v;
        u32x2 w; w.x = cvt_pk_bf16(v[0], v[1]); w.y = cvt_pk_bf16(v[2], v[3]); *(u32x2*)(hb + i * 4) = w;
    }
}

__device__ __forceinline__ void ln_phase(float* h32, bf16_t* hb, int M, const float* g, const float* b) {
    int tid = threadIdx.x; asm volatile("" : "+v"(tid));
    const int lane = tid & 63, wv = tid >> 6;
    f32x4 gv[4], bv[4];
#pragma unroll
    for (int i = 0; i < 4; ++i) { gv[i] = *(const f32x4*)(g + i * 256 + lane * 4); bv[i] = *(const f32x4*)(b + i * 256 + lane * 4); }
    for (int row = blockIdx.x * 8 + wv; row < M; row += gridDim.x * 8) {
        float* p = h32 + (size_t)row * DM; f32x4 x[4]; float s = 0.f;
#pragma unroll
        for (int i = 0; i < 4; ++i) { x[i] = *(const f32x4*)(p + i * 256 + lane * 4); s += (x[i][0] + x[i][1]) + (x[i][2] + x[i][3]); }
#pragma unroll
        for (int o = 32; o >= 1; o >>= 1) s += __shfl_xor(s, o);
        const float mu = s * (1.0f / 1024.0f); float q = 0.f;
#pragma unroll
        for (int i = 0; i < 4; ++i) { const f32x4 d = x[i] - mu; q += (d[0] * d[0] + d[1] * d[1]) + (d[2] * d[2] + d[3] * d[3]); }
#pragma unroll
        for (int o = 32; o >= 1; o >>= 1) q += __shfl_xor(q, o);
        const float rstd = 1.0f / sqrtf(q * (1.0f / 1024.0f) + LN_EPS_);
#pragma unroll
        for (int i = 0; i < 4; ++i) { const f32x4 y = (x[i] - mu) * rstd * gv[i] + bv[i]; *(f32x4*)(p + i * 256 + lane * 4) = y;
            u32x2 w; w.x = cvt_pk_bf16(y[0], y[1]); w.y = cvt_pk_bf16(y[2], y[3]); *(u32x2*)(hb + (size_t)row * DM + i * 256 + lane * 4) = w; }
    }
}

constexpr int RS128 = 288, RSV = 528, RS64 = 160;
constexpr int L_QE = 0, L_KE = 18432, L_KD = 36864, L_V = 55296, L_ATT = 89088, L_ST = 99328, L_EBL = 140288, L_TOT = 140800, L_RED = 142848, L_PAR = 146944;
static_assert(L_RED + 4096 <= LDS_BYTES, "mixer LDS");

__device__ __forceinline__ bf16x8 tr_frag(unsigned addr, int) { return (bf16x8){0,0,0,0,0,0,0,0}; }
__device__ __forceinline__ void tr_frag4(unsigned addr, const int o0, const int o1, const int o2, const int o3, const int step, bf16x8& f0, bf16x8& f1, bf16x8& f2, bf16x8& f3) {
    s16x4 a0, a1, a2, a3, b0, b1, b2, b3;
    asm volatile("ds_read_b64_tr_b16 %0, %8 offset:%9\n\tds_read_b64_tr_b16 %1, %8 offset:%10\n\tds_read_b64_tr_b16 %2, %8 offset:%11\n\tds_read_b64_tr_b16 %3, %8 offset:%12\n\t"
                 "ds_read_b64_tr_b16 %4, %8 offset:%13\n\tds_read_b64_tr_b16 %5, %8 offset:%14\n\tds_read_b64_tr_b16 %6, %8 offset:%15\n\tds_read_b64_tr_b16 %7, %8 offset:%16\n\ts_waitcnt lgkmcnt(0)"
                 : "=&v"(a0), "=&v"(b0), "=&v"(a1), "=&v"(b1), "=&v"(a2), "=&v"(b2), "=&v"(a3), "=&v"(b3)
                 : "v"(addr), "i"(o0), "i"(o0 + step), "i"(o1), "i"(o1 + step), "i"(o2), "i"(o2 + step), "i"(o3), "i"(o3 + step) : "memory");
    f0 = (bf16x8){a0[0], a0[1], a0[2], a0[3], b0[0], b0[1], b0[2], b0[3]}; f1 = (bf16x8){a1[0], a1[1], a1[2], a1[3], b1[0], b1[1], b1[2], b1[3]};
    f2 = (bf16x8){a2[0], a2[1], a2[2], a2[3], b2[0], b2[1], b2[2], b2[3]}; f3 = (bf16x8){a3[0], a3[1], a3[2], a3[3], b3[0], b3[1], b3[2], b3[3]};
}
__device__ __forceinline__ void unpack8(const u32x4 w, float (&f)[8]) { f[0] = bf_lo(w.x); f[1] = bf_hi(w.x); f[2] = bf_lo(w.y); f[3] = bf_hi(w.y); f[4] = bf_lo(w.z); f[5] = bf_hi(w.z); f[6] = bf_lo(w.w); f[7] = bf_hi(w.w); }
__device__ __forceinline__ u32x4 pack8(const float (&f)[8]) { u32x4 w; w.x = cvt_pk_bf16(f[0], f[1]); w.y = cvt_pk_bf16(f[2], f[3]); w.z = cvt_pk_bf16(f[4], f[5]); w.w = cvt_pk_bf16(f[6], f[7]); return w; }

struct MixItem { int head, row0, nch, L, pos0; const float* Sin; float* Sout; };

template <bool RET>
__device__ __forceinline__ void mixer_item(LAS unsigned char* lds, const MixItem it, const bf16_t* Q, const bf16_t* K, const bf16_t* V, const bf16_t* LG, bf16_t* R,
                           const float* balpha, const float* gn, const float* trig) {
    int tid = threadIdx.x; asm volatile("" : "+v"(tid));
    const int lane = tid & 63, w = __builtin_amdgcn_readfirstlane(tid >> 6), fr = lane & 15, fq = lane >> 4;
    const int tl = tid >> 3, iseg = tid & 7, i0 = iseg * 8;
    const int head = it.head, L = it.L;
    const unsigned ldsb = (unsigned)(size_t)lds;
    const unsigned tr_lane = (unsigned)((8 * fq + ((lane & 15) >> 2)));
    const int tp = lane & 3;
    const unsigned trb_v = ldsb + L_V + tr_lane * RSV + 8 * tp + 64 * w, trb_k = ldsb + L_KD + tr_lane * RS128 + 8 * tp;
    const float scale = 0.08838834764831845f;
    const float lgam = head == 0 ? -0.0317486983145803f : (head == 1 ? -0.015748356968139168f : (head == 2 ? -0.007843177461025893f : -0.003913899321136329f));
    f32x4 S[8][2];
    {
        const GAS float* sp = (const GAS float*)(it.Sin ? it.Sin + (size_t)(4 * fq) * 256 + 32 * w + fr : nullptr);
#pragma unroll
        for (int di = 0; di < 8; ++di) {
            const GAS float* pd = sp + di * 4096; asm volatile("" : "+v"(pd));
#pragma unroll
            for (int ei = 0; ei < 2; ++ei)
#pragma unroll
                for (int j = 0; j < 4; ++j) S[di][ei][j] = sp ? pd[j * 256 + 16 * ei] : 0.f;
        }
    }

    const bool valid = tl < L;
    { LAS float* PAR = (LAS float*)(lds + L_PAR);
      if (tid < 128) PAR[tid] = RET ? 0.f : balpha[head * 128 + tid];
      if (tid >= 128 && tid < 384) PAR[tid] = gn[head * 256 + tid - 128]; }
    __syncthreads();
    u32x4 pq[4] = {(u32x4){0u, 0u, 0u, 0u}, (u32x4){0u, 0u, 0u, 0u}, (u32x4){0u, 0u, 0u, 0u}, (u32x4){0u, 0u, 0u, 0u}};
    u32x4 pl[2] = {(u32x4){0u, 0u, 0u, 0u}, (u32x4){0u, 0u, 0u, 0u}};
    f32x4 ptr[4] = {(f32x4){0.f, 0.f, 0.f, 0.f}, (f32x4){0.f, 0.f, 0.f, 0.f}, (f32x4){0.f, 0.f, 0.f, 0.f}, (f32x4){0.f, 0.f, 0.f, 0.f}};
#define MIX_LOAD(cc) do { if (valid) { const size_t row_ = (size_t)it.row0 + (cc) * 64 + tl; \
        const bf16_t* qp_ = Q + row_ * 512 + head * 128 + i0; pq[0] = *(const u32x4*)qp_; pq[1] = *(const u32x4*)(qp_ + 64); \
        const bf16_t* kp_ = K + row_ * 512 + head * 128 + i0; pq[2] = *(const u32x4*)kp_; pq[3] = *(const u32x4*)(kp_ + 64); \
        if (!RET) { const bf16_t* lp_ = LG + row_ * 512 + head * 128 + i0; pl[0] = *(const u32x4*)lp_; pl[1] = *(const u32x4*)(lp_ + 64); } \
        else { const float* cp_ = trig + (size_t)(it.pos0 + (cc) * 64 + tl) * 64 + i0; ptr[0] = *(const f32x4*)cp_; ptr[1] = *(const f32x4*)(cp_ + 4); ptr[2] = *(const f32x4*)(cp_ + NPOS * 64); ptr[3] = *(const f32x4*)(cp_ + NPOS * 64 + 4); } } } while (0)
    MIX_LOAD(0);
    for (int c = 0; c < it.nch; ++c) {
        u32x4 pv[4] = {(u32x4){0u, 0u, 0u, 0u}, (u32x4){0u, 0u, 0u, 0u}, (u32x4){0u, 0u, 0u, 0u}, (u32x4){0u, 0u, 0u, 0u}};
        if (valid) { const bf16_t* vp_ = V + ((size_t)it.row0 + c * 64 + tl) * 1024 + head * 256 + iseg * 32; pv[0] = *(const u32x4*)vp_; pv[1] = *(const u32x4*)(vp_ + 8); pv[2] = *(const u32x4*)(vp_ + 16); pv[3] = *(const u32x4*)(vp_ + 24); }
        const u32x4 qk[4] = {pq[0], pq[1], pq[2], pq[3]};
        if (!RET) {
            LAS float* BS = (LAS float*)(lds + L_ST);
#pragma unroll
            for (int h = 0; h < 2; ++h) {
                float lA[8]; unpack8(pl[h], lA);
                const f32x4 ba0 = *(const LAS f32x4*)(lds + L_PAR + (64 * h + i0) * 4), ba1 = *(const LAS f32x4*)(lds + L_PAR + (64 * h + i0 + 4) * 4);
#pragma unroll
                for (int j = 0; j < 8; ++j) { const float xa = lA[j] + (j < 4 ? ba0[j & 3] : ba1[j & 3]);
                    lA[j] = valid ? (fminf(xa, 0.f) - __logf(1.0f + __expf(-fabsf(xa)))) * 0.0625f : 0.f; }
                *(LAS f32x4*)(BS + tl * 132 + 64 * h + i0) = (f32x4){lA[0], lA[1], lA[2], lA[3]}; *(LAS f32x4*)(BS + tl * 132 + 64 * h + i0 + 4) = (f32x4){lA[4], lA[5], lA[6], lA[7]};
            }
            __syncthreads();
            { const int d = tid & 127, sg = tid >> 7; float pr[16];
#pragma unroll
              for (int j = 0; j < 16; ++j) pr[j] = BS[(16 * sg + j) * 132 + d];
#pragma unroll
              for (int j = 1; j < 16; ++j) pr[j] += pr[j - 1];
#pragma unroll
              for (int j = 0; j < 16; ++j) BS[(16 * sg + j) * 132 + d] = pr[j];
              ((LAS float*)(lds + L_TOT))[sg * 128 + d] = pr[15]; }
            __syncthreads();
            const LAS float* TOT = (const LAS float*)(lds + L_TOT); const int sgt = tl >> 4;
#pragma unroll
            for (int h = 0; h < 2; ++h) {
                float qh[8], kh[8], oq[8], ok[8], od[8], oe[8]; unpack8(qk[h], qh); unpack8(qk[2 + h], kh);
                const int db = 64 * h + i0;
#pragma unroll
                for (int j = 0; j < 8; ++j) {
                    const float t0 = TOT[db + j], t1 = TOT[128 + db + j], t2 = TOT[256 + db + j], t3 = TOT[384 + db + j];
                    const float ba = BS[tl * 132 + db + j] + (sgt > 0 ? t0 : 0.f) + (sgt > 1 ? t1 : 0.f) + (sgt > 2 ? t2 : 0.f);
                    const float bla = (t0 + t1) + (t2 + t3);
                    const float en = __expf(-ba); oe[j] = __expf(bla); oq[j] = qh[j] * __expf(ba) * scale; ok[j] = kh[j] * en; od[j] = kh[j] * (en * oe[j]);
                }
                *(LAS u32x4*)(lds + L_QE + tl * RS128 + db * 2) = pack8(oq); *(LAS u32x4*)(lds + L_KE + tl * RS128 + db * 2) = pack8(ok); *(LAS u32x4*)(lds + L_KD + tl * RS128 + db * 2) = pack8(od);
                if (tl == 0) { LAS float* E = (LAS float*)(lds + L_EBL); *(LAS f32x4*)(E + db) = (f32x4){oe[0], oe[1], oe[2], oe[3]}; *(LAS f32x4*)(E + db + 4) = (f32x4){oe[4], oe[5], oe[6], oe[7]}; }
                asm volatile("" ::: "memory");
            }
        } else {
            const f32x4 c0 = ptr[0], c1 = ptr[1], s0 = ptr[2], s1 = ptr[3];
            const float bt = (float)((tl < L ? tl : L - 1) + 1) * lgam, bl = (float)L * lgam;
            const float eq = __expf(bt), ek = __expf(-bt) * scale, ekd = __expf(bl - bt) * scale, ebl = __expf(bl);
            float qA[8], qB[8], kA[8], kB[8];
            unpack8(qk[0], qA); unpack8(qk[1], qB); unpack8(qk[2], kA); unpack8(qk[3], kB);
#pragma unroll
            for (int j = 0; j < 8; ++j) {
                const float cc = j < 4 ? c0[j & 3] : c1[j & 3], ss = j < 4 ? s0[j & 3] : s1[j & 3];
                const float qa = qA[j] * cc - qB[j] * ss, qb = qB[j] * cc + qA[j] * ss, ka = kA[j] * cc - kB[j] * ss, kb = kB[j] * cc + kA[j] * ss;
                qA[j] = qa; qB[j] = qb; kA[j] = ka; kB[j] = kb;
            }
            { float t[8];
#pragma unroll
              for (int j = 0; j < 8; ++j) t[j] = qA[j] * eq;
              *(LAS u32x4*)(lds + L_QE + tl * RS128 + i0 * 2) = pack8(t);
#pragma unroll
              for (int j = 0; j < 8; ++j) t[j] = qB[j] * eq;
              *(LAS u32x4*)(lds + L_QE + tl * RS128 + (64 + i0) * 2) = pack8(t);
#pragma unroll
              for (int j = 0; j < 8; ++j) t[j] = kA[j] * ek;
              *(LAS u32x4*)(lds + L_KE + tl * RS128 + i0 * 2) = pack8(t);
#pragma unroll
              for (int j = 0; j < 8; ++j) t[j] = kB[j] * ek;
              *(LAS u32x4*)(lds + L_KE + tl * RS128 + (64 + i0) * 2) = pack8(t);
#pragma unroll
              for (int j = 0; j < 8; ++j) t[j] = kA[j] * ekd;
              *(LAS u32x4*)(lds + L_KD + tl * RS128 + i0 * 2) = pack8(t);
#pragma unroll
              for (int j = 0; j < 8; ++j) t[j] = kB[j] * ekd;
              *(LAS u32x4*)(lds + L_KD + tl * RS128 + (64 + i0) * 2) = pack8(t); }
            if (tl == 0) { LAS float* E = (LAS float*)(lds + L_EBL); const f32x4 e4 = (f32x4){ebl, ebl, ebl, ebl};
                *(LAS f32x4*)(E + i0) = e4; *(LAS f32x4*)(E + i0 + 4) = e4; *(LAS f32x4*)(E + 64 + i0) = e4; *(LAS f32x4*)(E + 64 + i0 + 4) = e4; }
        }
        { LAS unsigned char* vd = lds + L_V + tl * RSV + iseg * 64; *(LAS u32x4*)vd = pv[0]; *(LAS u32x4*)(vd + 16) = pv[1]; *(LAS u32x4*)(vd + 32) = pv[2]; *(LAS u32x4*)(vd + 48) = pv[3]; }
        __syncthreads();

        if (c + 1 < it.nch) MIX_LOAD(c + 1);
#pragma unroll
        for (int q2 = 0; q2 < 2; ++q2) {
            const int idx = 2 * w + q2, si = idx >> 2, ti = idx & 3;
            f32x4 a = (f32x4){0.f, 0.f, 0.f, 0.f};
            if (ti >= si) {
#pragma unroll
                for (int kk = 0; kk < 4; ++kk) {
                    const bf16x8 af = *(const LAS bf16x8*)(lds + L_KE + (16 * si + fr) * RS128 + (32 * kk + 8 * fq) * 2);
                    const bf16x8 bf = *(const LAS bf16x8*)(lds + L_QE + (16 * ti + fr) * RS128 + (32 * kk + 8 * fq) * 2);
                    a = __builtin_amdgcn_mfma_f32_16x16x32_bf16(af, bf, a, 0, 0, 0);
                }
            }
#pragma unroll
            for (int j = 0; j < 4; ++j) if (16 * si + 4 * fq + j > 16 * ti + fr) a[j] = 0.f;
            u32x2 pw; pw.x = cvt_pk_bf16(a[0], a[1]); pw.y = cvt_pk_bf16(a[2], a[3]);
            *(LAS u32x2*)(lds + L_ATT + (16 * ti + fr) * RS64 + (16 * si + 4 * fq) * 2) = pw;
        }
        f32x4 O[2][4];
#pragma unroll
        for (int ei = 0; ei < 2; ++ei)
#pragma unroll
            for (int ti = 0; ti < 4; ++ti) O[ei][ti] = (f32x4){0.f, 0.f, 0.f, 0.f};
        LAS unsigned char* STw = lds + L_ST + w * (32 * RS64);
#pragma unroll
        for (int half = 0; half < 2; ++half) {
#pragma unroll
            for (int d4 = 0; d4 < 4; ++d4)
#pragma unroll
                for (int ei = 0; ei < 2; ++ei) { const f32x4 s = S[4 * half + d4][ei]; u32x2 pw; pw.x = cvt_pk_bf16(s[0], s[1]); pw.y = cvt_pk_bf16(s[2], s[3]);
                    *(LAS u32x2*)(STw + (16 * ei + fr) * RS64 + (16 * d4 + 4 * fq) * 2) = pw; }
            asm volatile("s_waitcnt lgkmcnt(0)" ::: "memory");
#pragma unroll
            for (int kk = 0; kk < 2; ++kk) {
                bf16x8 af[2];
#pragma unroll
                for (int ei = 0; ei < 2; ++ei) af[ei] = *(const LAS bf16x8*)(STw + (16 * ei + fr) * RS64 + (32 * kk + 8 * fq) * 2);
#pragma unroll
                for (int ti = 0; ti < 4; ++ti) { const bf16x8 bf = *(const LAS bf16x8*)(lds + L_QE + (16 * ti + fr) * RS128 + (64 * half + 32 * kk + 8 * fq) * 2);
#pragma unroll
                    for (int ei = 0; ei < 2; ++ei) O[ei][ti] = __builtin_amdgcn_mfma_f32_16x16x32_bf16(af[ei], bf, O[ei][ti], 0, 0, 0); }
            }
            asm volatile("s_waitcnt lgkmcnt(0)" ::: "memory");
        }
        __syncthreads();
        bf16x8 vf[2][2];
        tr_frag4(trb_v, 0, 32 * RSV, 32, 32 * RSV + 32, 4 * RSV, vf[0][0], vf[0][1], vf[1][0], vf[1][1]);
#pragma unroll
        for (int kk = 0; kk < 2; ++kk)
#pragma unroll
            for (int ti = 0; ti < 4; ++ti) { const bf16x8 bf = *(const LAS bf16x8*)(lds + L_ATT + (16 * ti + fr) * RS64 + (32 * kk + 8 * fq) * 2);
#pragma unroll
                for (int ei = 0; ei < 2; ++ei) O[ei][ti] = __builtin_amdgcn_mfma_f32_16x16x32_bf16(vf[ei][kk], bf, O[ei][ti], 0, 0, 0); }
        u32x2 rg[2][4];
        GAS bf16_t* Rc = (GAS bf16_t*)(R + ((size_t)it.row0 + c * 64 + fr) * 1024 + head * 256 + 32 * w + 4 * fq); asm volatile("" : "+v"(Rc));
#pragma unroll
        for (int ei = 0; ei < 2; ++ei)
#pragma unroll
            for (int ti = 0; ti < 4; ++ti) { const int t = 16 * ti + fr; rg[ei][ti] = (u32x2){0u, 0u};
                if (t < L) rg[ei][ti] = *(const GAS u32x2*)(Rc + ti * 16384 + 16 * ei); }
#pragma unroll
        for (int dp = 0; dp < 4; ++dp) {
            bf16x8 kf[2][2];
            tr_frag4(trb_k, 64 * dp, 32 * RS128 + 64 * dp, 64 * dp + 32, 32 * RS128 + 64 * dp + 32, 4 * RS128, kf[0][0], kf[0][1], kf[1][0], kf[1][1]);
#pragma unroll
            for (int dd = 0; dd < 2; ++dd) { const int di = 2 * dp + dd;
                const f32x4 eb = *(const LAS f32x4*)(lds + L_EBL + (16 * di + 4 * fq) * 4);
#pragma unroll
                for (int ei = 0; ei < 2; ++ei) S[di][ei] = S[di][ei] * eb;
#pragma unroll
                for (int kk = 0; kk < 2; ++kk)
#pragma unroll
                    for (int ei = 0; ei < 2; ++ei) S[di][ei] = __builtin_amdgcn_mfma_f32_16x16x32_bf16(kf[dd][kk], vf[ei][kk], S[di][ei], 0, 0, 0);
            }
        }
        { LAS f32x2* RED = (LAS f32x2*)(lds + L_RED);
#pragma unroll
          for (int ti = 0; ti < 4; ++ti) { float s1 = 0.f, s2 = 0.f;
#pragma unroll
              for (int ei = 0; ei < 2; ++ei)
#pragma unroll
                  for (int j = 0; j < 4; ++j) { const float x = O[ei][ti][j]; s1 += x; s2 += x * x; }
              s1 += __shfl_xor(s1, 16); s2 += __shfl_xor(s2, 16); s1 += __shfl_xor(s1, 32); s2 += __shfl_xor(s2, 32);
              if (fq == 0) RED[w * 64 + 16 * ti + fr] = (f32x2){s1, s2}; }
          __syncthreads();
#pragma unroll
          for (int ti = 0; ti < 4; ++ti) { const int t = 16 * ti + fr; float s1 = 0.f, s2 = 0.f;
#pragma unroll
              for (int ww = 0; ww < 8; ++ww) { const f32x2 p = RED[ww * 64 + t]; s1 += p.x; s2 += p.y; }
              const float mu = s1 * (1.0f / 256.0f), var = fmaxf(s2 * (1.0f / 256.0f) - mu * mu, 0.f), rstd = 1.0f / sqrtf(var + GN_EPS_);
              if (t < L) {
#pragma unroll
                  for (int ei = 0; ei < 2; ++ei) { const int e = 32 * w + 16 * ei + 4 * fq; const f32x4 g = *(const LAS f32x4*)(lds + L_PAR + (128 + e) * 4); const f32x4 o = O[ei][ti];
                      const float r0 = bf_lo(rg[ei][ti].x), r1 = bf_hi(rg[ei][ti].x), r2 = bf_lo(rg[ei][ti].y), r3 = bf_hi(rg[ei][ti].y);
                      u32x2 pw; pw.x = cvt_pk_bf16(fast_silu(r0) * ((o[0] - mu) * rstd * g[0]), fast_silu(r1) * ((o[1] - mu) * rstd * g[1]));
                      pw.y = cvt_pk_bf16(fast_silu(r2) * ((o[2] - mu) * rstd * g[2]), fast_silu(r3) * ((o[3] - mu) * rstd * g[3]));
                      *(GAS u32x2*)(Rc + ti * 16384 + 16 * ei) = pw; } }
          } }
    }
    {
        GAS float* sp = (GAS float*)(it.Sout + (size_t)(4 * fq) * 256 + 32 * w + fr);
#pragma unroll
        for (int di = 0; di < 8; ++di) {
            GAS float* pd = sp + di * 4096; asm volatile("" : "+v"(pd));
#pragma unroll
            for (int ei = 0; ei < 2; ++ei)
#pragma unroll
                for (int j = 0; j < 4; ++j) pd[j * 256 + 16 * ei] = S[di][ei][j];
        }
    }
    __syncthreads();
}

__device__ __forceinline__ void mixer_phase(LAS unsigned char* lds, int set, int l, bf16_t* Z, int M) {
    const int nitems = set == 0 ? 72 : 128;
    bf16_t* qg = Z; bf16_t* kg = Z + (size_t)M * 512; bf16_t* vg = Z + (size_t)M * 1024; bf16_t* rgp = Z + (size_t)M * 2048; bf16_t* lgp = Z + (size_t)M * 3072;
    bf16_t* qr = Z + (size_t)M * 3584; bf16_t* kr = Z + (size_t)M * 4096; bf16_t* vr = Z + (size_t)M * 4608; bf16_t* grp = Z + (size_t)M * 5632;
    const float* trig = (const float*)(CWS + WS_TRIG); float* smeta = (float*)(CWS + WS_SMETA);
    for (int itx = blockIdx.x; itx < nitems; itx += gridDim.x) {
        MixItem it; int ret;
        if (set == 0) {
            if (itx < 64) { ret = itx >> 5; const int bh = itx & 31, b = bh >> 2; it.head = bh & 3; it.row0 = b * 32; it.nch = 1; it.L = 32; it.pos0 = 1040;
                const size_t so = ((size_t)(l * 8 + b) * 4 + it.head) * 32768; it.Sin = CIN(ret ? 3 : 2) + so; it.Sout = COUT + (ret ? OUT_RET_S : OUT_GLA_S) + so; }
            else { const int j = itx - 64; ret = j >> 2; it.head = j & 3; it.row0 = 256; it.nch = 1; it.L = 16; it.pos0 = 0; it.Sin = nullptr; it.Sout = smeta + ((size_t)(l * 2 + ret) * 4 + it.head) * 32768; }
        } else {
            ret = itx >> 6; const int bh = itx & 63, b = bh >> 2; it.head = bh & 3; it.row0 = b * 2048; it.nch = 32; it.L = 64; it.pos0 = 16;
            it.Sin = smeta + ((size_t)(l * 2 + ret) * 4 + it.head) * 32768; it.Sout = COUT + (ret ? OUT_RET_P : OUT_GLA_P) + ((size_t)(l * 32 + (set - 1) * 16 + b) * 4 + it.head) * 32768;
        }
        if (ret) mixer_item<true>(lds, it, qr, kr, vr, nullptr, grp, nullptr, CIN(14) + (size_t)l * 1024, trig);
        else mixer_item<false>(lds, it, qg, kg, vg, lgp, rgp, CIN(11) + (size_t)l * 512, CIN(13) + (size_t)l * 1024, trig);
    }
}

#define SET_M   (set == 0 ? MSMALL : MBIG)
#define SET_H   (set == 0 ? COUT + OUT_YS : COUT + OUT_YP + (size_t)(set - 1) * MBIG * DM)
#define P_HB    ((bf16_t*)(CWS + WS_HB))
#define P_Z     ((bf16_t*)(CWS + WS_Z))
#define P_W     ((const bf16_t*)(CWS + WS_W) + (size_t)l * W_LAYER)
#define GEMM(EPI, A_, B_, N_, K_, ...) do { const int M = SET_M; pg8::Gemm g{A_, B_, M, N_, K_}; pg8::StaticOrder S; S.init(M, N_, (int)gridDim.x, (int)blockIdx.x); EPI E{__VA_ARGS__}; pg8::gemm_phase<EPI, pg8::StaticOrder>(lds, g, S, E, nullptr); } while (0)
__global__ void __launch_bounds__(512, 2) fwd_megakernel(Args a, int ph_lo, int ph_hi) {
    extern __shared__ __attribute__((aligned(16))) unsigned char shm[];
    LAS unsigned char* lds = (LAS unsigned char*)shm;
    cg::grid_group grid = cg::this_grid();
    if (threadIdx.x < 20) *(LAS unsigned long long*)(lds + CTX_OFF + 8 * threadIdx.x) = (unsigned long long)a.in[threadIdx.x];
    if (threadIdx.x == 20) *(LAS unsigned long long*)(lds + CTX_OFF + 8 * 20) = (unsigned long long)a.out;
    if (threadIdx.x == 21) *(LAS unsigned long long*)(lds + CTX_OFF + 8 * 21) = (unsigned long long)a.ws;
    if (threadIdx.x == 0) { *(LAS unsigned*)(lds + CTX_OFF + 192) = 0u; *(LAS unsigned*)(lds + CTX_OFF + 196) = 0u; }
    __syncthreads();
    const XcdBarrier bar = xcd_barrier_post((unsigned*)(a.ws + WS_CTL), (volatile LAS unsigned*)(lds + CTX_OFF + 192));
    int ph = 0;
#define PHASE(...) do { if (ph >= ph_lo && ph < ph_hi) { __VA_ARGS__; if (ph + 1 < ph_hi) { if (ph == 0) grid.sync(); else xcd_barrier(bar); } } ++ph; } while (0)
    PHASE(prologue(lds));
    for (int set = 0; set < 3; ++set) {
        PHASE(init_set(lds, set, SET_H, P_HB));
        for (int l = 0; l < DEPTH_; ++l) {
            PHASE(GEMM(pg8::EpiSwiglu, P_HB, P_W + W_UP1, 2 * DFF, DM, P_Z, DFF));
            PHASE(GEMM(pg8::EpiResid, P_Z, P_W + W_DN1, DM, DFF, SET_H, DN_ALPHA_, 0.5f));
            PHASE(ln_phase(SET_H, P_HB, SET_M, CIN(5) + (size_t)l * 3 * DM, CIN(6) + (size_t)l * 3 * DM));
            PHASE(GEMM(pg8::EpiZ, P_HB, P_W + W_IN, NZ, DM, P_Z, M));
            PHASE(mixer_phase(lds, set, l, P_Z, SET_M));
            PHASE(GEMM(pg8::EpiGate<false>, P_Z + (size_t)M * 2048, P_W + W_OA, DM, DM, P_Z + (size_t)M * 6656, CIN(12) + (size_t)l * 2048, 0, nullptr, P_Z + (size_t)M * 1024));
            PHASE(GEMM(pg8::EpiGate<true>, P_Z + (size_t)M * 5632, P_W + W_OB, DM, DM, P_Z + (size_t)M * 6656, CIN(12) + (size_t)l * 2048, 1024, P_Z + (size_t)M * 1024, P_Z + (size_t)M * 4608));
            PHASE(GEMM(pg8::EpiResid, P_Z + (size_t)M * 4608, P_W + W_O, DM, DM, SET_H, DN_ALPHA_, 1.0f));
            PHASE(ln_phase(SET_H, P_HB, SET_M, CIN(5) + (size_t)(l * 3 + 1) * DM, CIN(6) + (size_t)(l * 3 + 1) * DM));
            PHASE(GEMM(pg8::EpiSwiglu, P_HB, P_W + W_UP2, 2 * DFF, DM, P_Z, DFF));
            PHASE(GEMM(pg8::EpiResid, P_Z, P_W + W_DN2, DM, DFF, SET_H, DN_ALPHA_, 0.5f));
            PHASE(ln_phase(SET_H, P_HB, SET_M, CIN(5) + (size_t)(l * 3 + 2) * DM, CIN(6) + (size_t)(l * 3 + 2) * DM));
        }
    }
#undef PHASE
}
constexpr int N_PHASES = 1 + 3 * (1 + 4 * 12);

extern "C" void kernel_launch(void* const* d_in, const int* in_sizes, int n_in, void* d_out, int out_size, void* d_ws, size_t ws_size, hipStream_t stream) {
    static int grid = 0;
    if (grid == 0) {
        int dev = 0, cus = 0, per_cu = 0;
        hipGetDevice(&dev); hipDeviceGetAttribute(&cus, hipDeviceAttributeMultiprocessorCount, dev);
        hipFuncSetAttribute((const void*)fwd_megakernel, hipFuncAttributeMaxDynamicSharedMemorySize, LDS_BYTES);
        hipOccupancyMaxActiveBlocksPerMultiprocessor(&per_cu, (const void*)fwd_megakernel, 512, LDS_BYTES);
        if (per_cu < 1) per_cu = 1;
        grid = cus * (per_cu > 1 ? 1 : per_cu);
        if (ws_size < WS_END) { fprintf(stderr, "kernel_launch: workspace too small: %zu < %zu\n", ws_size, (size_t)WS_END); }
        (void)hipGetLastError();
    }
    (void)hipMemsetAsync((char*)d_ws + WS_CTL, 0, 16384, stream);
    Args a{};
    for (int i = 0; i < 20; ++i) a.in[i] = (const float*)d_in[i];
    a.out = (float*)d_out; a.ws = (unsigned char*)d_ws;
    int lo = 0, hi = N_PHASES;
    void* args[] = {&a, &lo, &hi};
    hipError_t e = hipLaunchCooperativeKernel((const void*)fwd_megakernel, dim3(grid), dim3(512), args, LDS_BYTES, stream);
    if (e != hipSuccess) fprintf(stderr, "cooperative launch failed: %s (grid %d)\n", hipGetErrorString(e), grid);
}
```
